# Optimizing an MI355X kernel written in HIP

```python
import jax, jax.numpy as jnp
from jax import lax
import numpy as np

D_MODEL = 1024
BATCH = 8
SEQ = 2048
DEPTH = 4

N_MIXERS = 4
HEAD_DIM = 128
CHUNK = 64
GLA_HEADS = 4
GLA_DK = D_MODEL // 2 // GLA_HEADS
GLA_DV = D_MODEL // GLA_HEADS
GLA_GATE_RANK = 16
GLA_GATE_NORMALIZER = 16.0
GLA_COLS = (GLA_HEADS * GLA_DK, GLA_HEADS * GLA_DK, GLA_HEADS * GLA_DV, GLA_HEADS * GLA_DV, GLA_GATE_RANK)
MOBA_HEADS = D_MODEL // HEAD_DIM
MOBA_BLOCK = 256
MOBA_TOPK = 3
MOBA_QCHUNK = 16
MOBA_COLS = (D_MODEL, D_MODEL, D_MODEL)
ROPE_THETA = 500000.0
ROPE_DIM = HEAD_DIM // 4
NEG_INF = -1e30
GDN_HEADS = D_MODEL // HEAD_DIM
GDN_DK = HEAD_DIM
GDN_WIDTH = GDN_HEADS * GDN_DK
GDN_CONV = 4
GDN_COLS = (3 * GDN_WIDTH, GDN_WIDTH, GDN_HEADS, GDN_HEADS)
HGRN_HEADS = 8
HGRN_F_DIM = 128
HGRN_F = HGRN_HEADS * HGRN_F_DIM
HGRN_COLS = (HGRN_F, HGRN_F, D_MODEL, D_MODEL)
FFN_HIDDEN = -(-8 * D_MODEL // (3 * 256)) * 256
DEEPNORM_ALPHA = (2.0 * DEPTH) ** 0.25
DEEPNORM_BETA = (8.0 * DEPTH) ** -0.25
N_GLA = len(range(0, DEPTH, N_MIXERS))
N_MOBA = len(range(1, DEPTH, N_MIXERS))
N_GDN = len(range(2, DEPTH, N_MIXERS))
N_HGRN = len(range(3, DEPTH, N_MIXERS))

kernel_name = "hybrid_gla_moba_gdn_hgrn2_deepnorm"


def split_cols(x, cols):
    return jnp.split(x, [int(c) for c in np.cumsum(cols)[:-1]], axis=-1)


def to_heads(x, h):
    b, s, _ = x.shape
    return x.reshape(b, s, h, -1).transpose(0, 2, 1, 3)


def from_heads(x):
    b, h, s, d = x.shape
    return x.transpose(0, 2, 1, 3).reshape(b, s, h * d)


def layer_norm(x, g, b, eps=1e-5):
    xf = x.astype(jnp.float32)
    mu = jnp.mean(xf, -1, keepdims=True)
    var = jnp.mean(jnp.square(xf - mu), -1, keepdims=True)
    return ((xf - mu) * lax.rsqrt(var + eps) * g + b).astype(x.dtype)


def rms_norm(x, g, eps=1e-6):
    xf = x.astype(jnp.float32)
    return (xf * lax.rsqrt(jnp.mean(xf * xf, -1, keepdims=True) + eps) * g).astype(x.dtype)


def l2_normalize(x, eps=1e-6):
    xf = x.astype(jnp.float32)
    return (xf * lax.rsqrt(jnp.sum(xf * xf, -1, keepdims=True) + eps)).astype(x.dtype)


def partial_rope(x, positions):
    inv_freq = ROPE_THETA ** (-jnp.arange(0, ROPE_DIM, 2, dtype=jnp.float32) / ROPE_DIM)
    ang = positions.astype(jnp.float32)[:, None, :, None] * inv_freq
    cos, sin = jnp.cos(ang), jnp.sin(ang)
    xr = x[..., :ROPE_DIM].astype(jnp.float32)
    x1, x2 = xr[..., :ROPE_DIM // 2], xr[..., ROPE_DIM // 2:]
    rot = jnp.concatenate([x1 * cos - x2 * sin, x2 * cos + x1 * sin], -1).astype(x.dtype)
    return jnp.concatenate([rot, x[..., ROPE_DIM:]], -1)


def causal_depthwise_conv(x, w):
    k, c = w.shape
    return lax.conv_general_dilated(x, w.reshape(k, 1, c).astype(x.dtype), window_strides=(1,),
                                    padding=((k - 1, 0),), dimension_numbers=("NWC", "WIO", "NWC"),
                                    feature_group_count=c)


def swiglu_ffn(x, w_gu, w_down):
    gate, up = jnp.split(x @ w_gu, 2, axis=-1)
    return (jax.nn.silu(gate) * up) @ w_down


def chunk_gla(q, k, v, log_g):
    b, h, s, dk = q.shape
    dv = v.shape[-1]
    n = s // CHUNK
    f32 = jnp.float32
    q, k, log_g = (t.astype(f32).reshape(b, h, n, CHUNK, dk) for t in (q, k, log_g))
    v = v.astype(f32).reshape(b, h, n, CHUNK, dv)
    cum = jnp.cumsum(log_g, axis=3)
    last = cum[:, :, :, -1:, :]
    q_dec = q * jnp.exp(cum)
    k_inv = k * jnp.exp(-cum)
    k_to_end = k * jnp.exp(last - cum)
    causal = jnp.tril(jnp.ones((CHUNK, CHUNK), bool))
    scores = jnp.where(causal, jnp.einsum("bhnik,bhnjk->bhnij", q_dec, k_inv), 0.0)
    o_intra = jnp.einsum("bhnij,bhnjv->bhniv", scores, v)
    upd = jnp.einsum("bhnjk,bhnjv->bhnkv", k_to_end, v)
    decay = jnp.exp(last[:, :, :, 0, :])

    def step(state, inp):
        dec, u = inp
        return state * dec[..., None] + u, state

    _, states = lax.scan(step, jnp.zeros((b, h, dk, dv), f32),
                         (jnp.moveaxis(decay, 2, 0), jnp.moveaxis(upd, 2, 0)))
    states = jnp.moveaxis(states, 0, 2)
    o_inter = jnp.einsum("bhnik,bhnkv->bhniv", q_dec, states)
    return (o_intra + o_inter).reshape(b, h, s, dv)


def chunk_gated_delta(q, k, v, g, beta):
    b, h, s, dk = q.shape
    dv = v.shape[-1]
    n = s // CHUNK
    f32 = jnp.float32
    q = q.astype(f32).reshape(b, h, n, CHUNK, dk)
    k = k.astype(f32).reshape(b, h, n, CHUNK, dk)
    v = v.astype(f32).reshape(b, h, n, CHUNK, dv)
    g = g.astype(f32).reshape(b, h, n, CHUNK)
    beta = beta.astype(f32).reshape(b, h, n, CHUNK)
    cum = jnp.cumsum(g, axis=-1)
    incl = jnp.tril(jnp.ones((CHUNK, CHUNK), bool))
    strict = jnp.tril(jnp.ones((CHUNK, CHUNK), bool), -1)
    diff = cum[..., :, None] - cum[..., None, :]
    decay = jnp.where(incl, jnp.exp(jnp.where(incl, diff, 0.0)), 0.0)
    k_beta = k * beta[..., None]
    lower = jnp.where(strict, jnp.einsum("bhnid,bhnjd->bhnij", k_beta, k) * decay, 0.0)
    eye = jnp.eye(CHUNK, dtype=f32)
    rhs = jnp.concatenate([v * beta[..., None], k_beta * jnp.exp(cum)[..., None]], axis=-1)
    sol = lax.linalg.triangular_solve(lower + eye, rhs, left_side=True, lower=True)
    u, w = sol[..., :dv], sol[..., dv:]
    qk = jnp.einsum("bhnid,bhnjd->bhnij", q, k) * decay
    q_dec = q * jnp.exp(cum)[..., None]
    k_end = k * jnp.exp(cum[..., -1:] - cum)[..., None]
    chunk_decay = jnp.exp(cum[..., -1])

    def step(state, inp):
        u_c, w_c, qk_c, qd_c, ke_c, dec_c = inp
        v_new = u_c - jnp.einsum("bhck,bhkv->bhcv", w_c, state)
        o_c = jnp.einsum("bhck,bhkv->bhcv", qd_c, state) + jnp.einsum("bhij,bhjv->bhiv", qk_c, v_new)
        state = state * dec_c[..., None, None] + jnp.einsum("bhck,bhcv->bhkv", ke_c, v_new)
        return state, o_c

    xs = tuple(jnp.moveaxis(t, 2, 0) for t in (u, w, qk, q_dec, k_end, chunk_decay))
    _, o = lax.scan(step, jnp.zeros((b, h, dk, dv), f32), xs)
    return jnp.moveaxis(o, 0, 2).reshape(b, h, s, dv)


def moba_attention(q, k, v):
    b, h, s, d = q.shape
    nb = -(-s // MOBA_BLOCK)
    s_pad = nb * MOBA_BLOCK
    pad = ((0, 0), (0, 0), (0, s_pad - s), (0, 0))
    q, k, v = (jnp.pad(t, pad) for t in (q, k, v))
    scale = HEAD_DIM ** -0.5
    k_blocks = k.reshape(b, h, nb, MOBA_BLOCK, d)
    v_blocks = v.reshape(b, h, nb, MOBA_BLOCK, d)
    k_mean = jnp.mean(k_blocks.astype(jnp.float32), axis=3)
    gate = jnp.einsum("bhsd,bhnd->bhsn", q.astype(jnp.float32), k_mean)
    q_block = jnp.arange(s_pad) // MOBA_BLOCK
    past = jnp.arange(nb)[None, :] < q_block[:, None]
    gate = jnp.where(past, gate, NEG_INF)
    n_sel = min(MOBA_TOPK, nb)
    _, sel = lax.top_k(gate, n_sel)
    bi = jnp.arange(b)[:, None, None, None]
    hi = jnp.arange(h)[None, :, None, None]

    def chunk_fn(ci):
        q0 = ci * MOBA_QCHUNK
        blk = q0 // MOBA_BLOCK
        q_c = lax.dynamic_slice_in_dim(q, q0, MOBA_QCHUNK, axis=2)
        k_own = lax.dynamic_slice_in_dim(k, blk * MOBA_BLOCK, MOBA_BLOCK, axis=2)
        v_own = lax.dynamic_slice_in_dim(v, blk * MOBA_BLOCK, MOBA_BLOCK, axis=2)
        sel_c = lax.dynamic_slice_in_dim(sel, q0, MOBA_QCHUNK, axis=2)
        k_sel = k_blocks[bi, hi, sel_c]
        v_sel = v_blocks[bi, hi, sel_c]
        own = jnp.einsum("bhqd,bhkd->bhqk", q_c, k_own, preferred_element_type=jnp.float32) * scale
        q_pos = q0 + jnp.arange(MOBA_QCHUNK)
        k_pos = blk * MOBA_BLOCK + jnp.arange(MOBA_BLOCK)
        own = jnp.where(k_pos[None, :] <= q_pos[:, None], own, NEG_INF)
        far = jnp.einsum("bhqd,bhqnkd->bhqnk", q_c, k_sel, preferred_element_type=jnp.float32) * scale
        far = jnp.where((jnp.arange(n_sel) < blk)[:, None], far, NEG_INF)
        logits = jnp.concatenate([own, far.reshape(b, h, MOBA_QCHUNK, n_sel * MOBA_BLOCK)], axis=-1)
        p = jax.nn.softmax(logits, axis=-1).astype(v.dtype)
        p_own = p[..., :MOBA_BLOCK]
        p_far = p[..., MOBA_BLOCK:].reshape(b, h, MOBA_QCHUNK, n_sel, MOBA_BLOCK)
        return (jnp.einsum("bhqk,bhkd->bhqd", p_own, v_own)
                + jnp.einsum("bhqnk,bhqnkd->bhqd", p_far, v_sel))

    out = lax.map(chunk_fn, jnp.arange(s_pad // MOBA_QCHUNK))
    out = jnp.moveaxis(out, 0, 2).reshape(b, h, s_pad, d)
    return out[:, :, :s]


def gla_mixer(x, w_in, w_gk, b_gk, norm_g, w_out):
    q, k, v, g, gk_low = split_cols(x @ w_in, GLA_COLS)
    log_a = jax.nn.log_sigmoid((gk_low @ w_gk + b_gk).astype(jnp.float32)) / GLA_GATE_NORMALIZER
    q = to_heads(q, GLA_HEADS) * (GLA_DK ** -0.5)
    o = chunk_gla(q, to_heads(k, GLA_HEADS), to_heads(v, GLA_HEADS), to_heads(log_a, GLA_HEADS))
    o = from_heads(rms_norm(o.astype(x.dtype), norm_g)) * jax.nn.silu(g)
    return o @ w_out


def moba_mixer(x, positions, w_in, w_out):
    q, k, v = split_cols(x @ w_in, MOBA_COLS)
    q = partial_rope(to_heads(q, MOBA_HEADS), positions)
    k = partial_rope(to_heads(k, MOBA_HEADS), positions)
    o = moba_attention(q, k, to_heads(v, MOBA_HEADS))
    return from_heads(o) @ w_out


def gdn_mixer(x, w_in, conv_w, a_log, dt_bias, norm_g, w_out):
    qkv, z, a, b_logit = split_cols(x @ w_in, GDN_COLS)
    qkv = jax.nn.silu(causal_depthwise_conv(qkv, conv_w))
    q, k, v = jnp.split(qkv, 3, axis=-1)
    q = l2_normalize(to_heads(q, GDN_HEADS)) * (GDN_DK ** -0.5)
    k = l2_normalize(to_heads(k, GDN_HEADS))
    v = to_heads(v, GDN_HEADS)
    beta = jax.nn.sigmoid(b_logit.astype(jnp.float32)).transpose(0, 2, 1)
    g = (-jnp.exp(a_log.astype(jnp.float32))
         * jax.nn.softplus(a.astype(jnp.float32) + dt_bias)).transpose(0, 2, 1)
    o = chunk_gated_delta(q, k, v, g, beta).astype(x.dtype)
    o = from_heads(rms_norm(o, norm_g)) * jax.nn.silu(z)
    return o @ w_out


def hgrn2_mixer(x, lb, w_in, norm_g, w_out):
    q, f_logit, i, g = split_cols(x @ w_in, HGRN_COLS)
    f_logit = f_logit.astype(jnp.float32)
    forget = lb + (1.0 - lb) * jax.nn.sigmoid(f_logit)
    k_in = (1.0 - lb) * jax.nn.sigmoid(-f_logit)
    o = chunk_gla(to_heads(q, HGRN_HEADS), to_heads(k_in, HGRN_HEADS), to_heads(i, HGRN_HEADS),
                  to_heads(jnp.log(forget), HGRN_HEADS))
    o = from_heads(rms_norm(o.astype(x.dtype), norm_g)) * jax.nn.silu(g)
    return o @ w_out


def setup_inputs(seed: int = 0) -> dict:
    key = jax.random.key(seed)
    ks = iter(jax.random.split(key, 32))
    f32 = jnp.float32

    def normal(shape):
        return jax.random.normal(next(ks), shape, f32)

    def dense(shape, fan_in, scale=1.0):
        return normal(shape) * (scale * fan_in ** -0.5)

    def gain(shape):
        return 1.0 + 0.02 * normal(shape)

    def small(shape):
        return 0.02 * normal(shape)

    x = normal((BATCH, SEQ, D_MODEL))
    offset = jax.random.randint(next(ks), (BATCH,), 0, 4096, dtype=jnp.int32)
    positions = offset[:, None] + jnp.arange(SEQ, dtype=jnp.int32)[None, :]
    a_init = jax.random.uniform(next(ks), (N_GDN, GDN_HEADS), f32, 1.0, 16.0)
    dt = jnp.exp(jax.random.uniform(next(ks), (N_GDN, GDN_HEADS), f32, float(np.log(1e-3)), float(np.log(1e-1))))
    return {
        "x": x,
        "positions": positions,
        "gla_w_in": dense((N_GLA, D_MODEL, sum(GLA_COLS)), D_MODEL),
        "gla_w_gk": dense((N_GLA, GLA_GATE_RANK, GLA_HEADS * GLA_DK), GLA_GATE_RANK),
        "gla_b_gk": small((N_GLA, GLA_HEADS * GLA_DK)),
        "gla_norm_g": gain((N_GLA, GLA_DV)),
        "gla_w_out": dense((N_GLA, GLA_HEADS * GLA_DV, D_MODEL), GLA_HEADS * GLA_DV, DEEPNORM_BETA),
        "moba_w_in": dense((N_MOBA, D_MODEL, sum(MOBA_COLS)), D_MODEL),
        "moba_w_out": dense((N_MOBA, D_MODEL, D_MODEL), D_MODEL, DEEPNORM_BETA),
        "gdn_w_in": dense((N_GDN, D_MODEL, sum(GDN_COLS)), D_MODEL),
        "gdn_conv_w": dense((N_GDN, GDN_CONV, 3 * GDN_WIDTH), GDN_CONV),
        "gdn_a_log": jnp.log(a_init),
        "gdn_dt_bias": dt + jnp.log(-jnp.expm1(-dt)),
        "gdn_norm_g": gain((N_GDN, GDN_DK)),
        "gdn_w_out": dense((N_GDN, GDN_WIDTH, D_MODEL), GDN_WIDTH, DEEPNORM_BETA),
        "hgrn_lower_bounds": small((DEPTH, HGRN_F)),
        "hgrn_w_in": dense((N_HGRN, D_MODEL, sum(HGRN_COLS)), D_MODEL),
        "hgrn_norm_g": gain((N_HGRN, D_MODEL // HGRN_HEADS)),
        "hgrn_w_out": dense((N_HGRN, D_MODEL, D_MODEL), D_MODEL, DEEPNORM_BETA),
        "ffn_w_gu": dense((DEPTH, D_MODEL, 2 * FFN_HIDDEN), D_MODEL),
        "ffn_w_down": dense((DEPTH, FFN_HIDDEN, D_MODEL), FFN_HIDDEN, DEEPNORM_BETA),
        "ln_g": gain((DEPTH, 2, D_MODEL)),
        "ln_b": small((DEPTH, 2, D_MODEL)),
    }


def reference(x, positions, gla_w_in, gla_w_gk, gla_b_gk, gla_norm_g, gla_w_out, moba_w_in, moba_w_out,
              gdn_w_in, gdn_conv_w, gdn_a_log, gdn_dt_bias, gdn_norm_g, gdn_w_out, hgrn_lower_bounds,
              hgrn_w_in, hgrn_norm_g, hgrn_w_out, ffn_w_gu, ffn_w_down, ln_g, ln_b):
    lb_soft = jax.nn.softmax(hgrn_lower_bounds.astype(jnp.float32), axis=0)
    lower_bounds = jnp.cumsum(lb_soft, axis=0) - lb_soft[0]
    for i in range(DEPTH):
        kind, j = i % N_MIXERS, i // N_MIXERS
        if kind == 0:
            y = gla_mixer(x, gla_w_in[j], gla_w_gk[j], gla_b_gk[j], gla_norm_g[j], gla_w_out[j])
        elif kind == 1:
            y = moba_mixer(x, positions, moba_w_in[j], moba_w_out[j])
        elif kind == 2:
            y = gdn_mixer(x, gdn_w_in[j], gdn_conv_w[j], gdn_a_log[j], gdn_dt_bias[j], gdn_norm_g[j], gdn_w_out[j])
        else:
            y = hgrn2_mixer(x, lower_bounds[i], hgrn_w_in[j], hgrn_norm_g[j], hgrn_w_out[j])
        x = layer_norm(DEEPNORM_ALPHA * x + y, ln_g[i, 0], ln_b[i, 0])
        x = layer_norm(DEEPNORM_ALPHA * x + swiglu_ffn(x, ffn_w_gu[i], ffn_w_down[i]), ln_g[i, 1], ln_b[i, 1])
    return x
```

```cpp
#include <hip/hip_runtime.h>
#include <cstdio>
#include <cstdint>
#define MK_N_LAUNCHES 33
#define DBG_SKIP 0
namespace pg8 {
#define PG8_LAS __attribute__((address_space(3)))
typedef unsigned short bf16_t;
typedef short bf16x8 __attribute__((ext_vector_type(8)));
typedef float f32x4 __attribute__((ext_vector_type(4)));
typedef unsigned u32x4 __attribute__((ext_vector_type(4)));
constexpr int BM = 256, BK = 64, HALF = 128, HTB = HALF * BK * 2  , STAGE_BYTES = 8 * HTB, NXCD = 8, WGM = 8;

__host__ __device__ __forceinline__ int lds_byte(int r, int c) { const int st = (r >> 4) * 2 + (c >> 5), rr = r & 15, cc = c & 31, ob = rr * 64 + cc * 2; return st * 1024 + (ob ^ (((ob >> 9) & 1) << 5)); }
__host__ __device__ __forceinline__ void stage_rc(int b, int& R, int& C) { const int st = b / 1024, sb = b % 1024, swz = sb ^ (((sb >> 9) & 1) << 5); R = (st >> 1) * 16 + swz / 64; C = (st & 1) * 32 + (swz % 64) / 2; }
__host__ __device__ __forceinline__ int perm32(int rho) { const int n = rho >> 4, i = rho & 15; return 8 * (i >> 2) + 4 * n + (i & 3); }

struct Unit { int pm, pn; };
struct Gemm { const bf16_t* A; const bf16_t* Bt; int M, N, K; };

struct StaticOrder {
    int nM, nN, nwg, G, c;
    __host__ __device__ void init(int M, int N, int G_, int c_) { nM = M / BM; nN = N / BM; nwg = nM * nN; G = G_; c = c_; }
    __host__ __device__ bool next(int i, Unit& u) const {
        const long L = (long)i * G + c; if (L >= nwg) return false;
        int wgid = (int)L; { const int q = nwg / NXCD, r = nwg % NXCD, xcd = wgid % NXCD, off = wgid / NXCD; wgid = (xcd < r ? xcd * (q + 1) : r * (q + 1) + (xcd - r) * q) + off; }
        const int nig = WGM * nN, gid = wgid / nig, fm = gid * WGM, gsz = (nM - fm) < WGM ? (nM - fm) : WGM;
        u.pm = fm + ((wgid % nig) % gsz); u.pn = (wgid % nig) / gsz; return true;
    }
    __device__ __forceinline__ void a_ready(const Unit&) const {}
    __device__ __forceinline__ void done(const Unit&) const {}
};
__device__ __forceinline__ unsigned cvt_pk_bf16(float lo, float hi) { unsigned r; asm volatile("v_cvt_pk_bf16_f32 %0, %1, %2" : "=v"(r) : "v"(lo), "v"(hi)); return r; }
typedef float f32x2 __attribute__((ext_vector_type(2)));
template <class Epi, class Sched, bool ALIGN_EPI = false, bool SP2 = false>
__device__ __forceinline__ void gemm_phase(PG8_LAS unsigned char* lds, const Gemm g, const Sched& S, const Epi& E) {
    const int tid = threadIdx.x, wid = __builtin_amdgcn_readfirstlane(tid >> 6), lane = tid & 63, wr = wid >> 2, wc = wid & 3, fr = lane & 15, fq = lane >> 4;
    const int K = g.K, nt = K / BK;
    unsigned voffA[2], voffB[2];
#pragma unroll
    for (int i = 0; i < 2; ++i) { int R, C; stage_rc(tid * 16 + i * 8192, R, C); const int Rb = Epi::PERM ? ((R & ~31) + perm32(R & 31)) : R;
        voffA[i] = (unsigned)(R * K + C) * 2u; voffB[i] = (unsigned)(Rb * K + C) * 2u; }
    const size_t kstep = (size_t)(BK * 2);
    const size_t hstep = (size_t)HALF * K * 2;
    const size_t tstep = 2 * hstep;
    const unsigned ldsw = (unsigned)wid * 1024u;
    const int aoff = lds_byte(wr * 64 + fr, fq * 8), boff = lds_byte(wc * 32 + fr, fq * 8);
#define PG8_SA(b, h) (((b) * 2 + (h)) * HTB)
#define PG8_SB(b, h) ((4 + (b) * 2 + (h)) * HTB)
#define PG8_STAGE(bufoff, gbase, voff) do { _Pragma("unroll") for (int _i = 0; _i < 2; ++_i) \
        __builtin_amdgcn_global_load_lds((const unsigned*)((const char*)(gbase) + (voff)[_i]), (PG8_LAS unsigned*)(lds + (bufoff) + ldsw + _i * 8192), 16, 0, 0); } while (0)
#define PG8_LDA(dst, b, h) do { _Pragma("unroll") for (int m = 0; m < 4; ++m) _Pragma("unroll") for (int k = 0; k < 2; ++k) dst[m][k] = *(const PG8_LAS bf16x8*)(lds + PG8_SA(b, h) + aoff + m * 2048 + k * 1024); } while (0)
#define PG8_LDB(dst, b, h) do { _Pragma("unroll") for (int n = 0; n < 2; ++n) _Pragma("unroll") for (int k = 0; k < 2; ++k) dst[n][k] = *(const PG8_LAS bf16x8*)(lds + PG8_SB(b, h) + boff + n * 2048 + k * 1024); } while (0)
#define PG8_MMA(ai, bj, At, Bt) do { __builtin_amdgcn_s_setprio(1); _Pragma("unroll") for (int m = 0; m < 4; ++m) _Pragma("unroll") for (int n = 0; n < 2; ++n) _Pragma("unroll") for (int k = 0; k < 2; ++k) \
        acc[ai][bj][m][n] = __builtin_amdgcn_mfma_f32_16x16x32_bf16(Bt[n][k], At[m][k], acc[ai][bj][m][n], 0, 0, 0); __builtin_amdgcn_s_setprio(0); } while (0)
#define PG8_WAIT_V(n) asm volatile("s_waitcnt vmcnt(" #n ")" ::: "memory")
#define PG8_WAIT_L(n) asm volatile("s_waitcnt lgkmcnt(" #n ")" ::: "memory")
#define PG8_BAR __builtin_amdgcn_s_barrier()
#define PG8_SCHED __builtin_amdgcn_sched_barrier(0)
    Unit cur, nxt; int ui = 0;
    if (!S.next(0, cur)) return;
    f32x4 acc[2][2][4][2];
#pragma unroll
    for (int a = 0; a < 2; ++a)
#pragma unroll
        for (int b = 0; b < 2; ++b)
#pragma unroll
            for (int m = 0; m < 4; ++m)
#pragma unroll
                for (int n = 0; n < 2; ++n) acc[a][b][m][n] = (f32x4){0.f, 0.f, 0.f, 0.f};
    bf16x8 At[4][2], B0[2][2], B1[2][2];
    const char* cA = (const char*)g.A + (size_t)cur.pm * tstep; const char* cB = (const char*)g.Bt + (size_t)cur.pn * tstep;
    S.a_ready(cur);
    if constexpr (SP2) {
        PG8_STAGE(PG8_SB(0, 0), cB, voffB); PG8_STAGE(PG8_SB(0, 1), cB + hstep, voffB); PG8_STAGE(PG8_SA(0, 0), cA, voffA); PG8_STAGE(PG8_SA(0, 1), cA + hstep, voffA);
        if (wr == 1) PG8_BAR;
        PG8_WAIT_V(2); PG8_BAR;
        PG8_STAGE(PG8_SB(1, 0), cB + kstep, voffB); PG8_STAGE(PG8_SA(1, 0), cA + kstep, voffA); PG8_STAGE(PG8_SB(1, 1), cB + hstep + kstep, voffB);
        PG8_WAIT_V(6); PG8_BAR;
    } else {
        PG8_STAGE(PG8_SB(0, 0), cB, voffB); PG8_STAGE(PG8_SA(0, 0), cA, voffA); PG8_STAGE(PG8_SB(0, 1), cB + hstep, voffB); PG8_STAGE(PG8_SA(0, 1), cA + hstep, voffA);
        if (wr == 1) PG8_BAR;
        PG8_WAIT_V(4); PG8_BAR;
        PG8_STAGE(PG8_SB(1, 0), cB + kstep, voffB); PG8_STAGE(PG8_SA(1, 0), cA + kstep, voffA); PG8_STAGE(PG8_SB(1, 1), cB + hstep + kstep, voffB);
        PG8_WAIT_V(6); PG8_BAR;
    }
    for (;;) {
        const bool has_next = S.next(ui + 1, nxt);
        const char* nA = has_next ? (const char*)g.A + (size_t)nxt.pm * tstep : cA; const char* nB = has_next ? (const char*)g.Bt + (size_t)nxt.pn * tstep : cB;
        for (int t = 0; t < nt; t += 2) {
            const bool last = (t == nt - 2);
            const char* a1 = cA + (size_t)(t + 1) * kstep;
            const char* a2 = last ? nA : cA + (size_t)(t + 2) * kstep; const char* b2 = last ? nB : cB + (size_t)(t + 2) * kstep;
            const char* a3 = a2 + kstep; const char* b3 = b2 + kstep;
            if (last && has_next) S.a_ready(nxt);
            if constexpr (SP2) {
            PG8_LDB(B0, 0, 0); PG8_LDB(B1, 0, 1); PG8_SCHED; PG8_LDA(At, 0, 0); PG8_STAGE(PG8_SA(1, 1), a1 + hstep, voffA);
            PG8_WAIT_V(8); PG8_WAIT_L(0); PG8_BAR; PG8_MMA(0, 0, At, B0); PG8_MMA(0, 1, At, B1); PG8_BAR; PG8_SCHED;
            PG8_LDA(At, 0, 1); PG8_STAGE(PG8_SB(0, 0), b2, voffB); PG8_STAGE(PG8_SB(0, 1), b2 + hstep, voffB); PG8_STAGE(PG8_SA(0, 0), a2, voffA);
            PG8_WAIT_V(8); PG8_WAIT_L(0); PG8_BAR; PG8_MMA(1, 0, At, B0); PG8_MMA(1, 1, At, B1); PG8_BAR; PG8_SCHED;
            PG8_LDB(B0, 1, 0); PG8_LDB(B1, 1, 1); PG8_SCHED; PG8_LDA(At, 1, 0); PG8_STAGE(PG8_SA(0, 1), a2 + hstep, voffA);
            PG8_WAIT_V(8); PG8_WAIT_L(0); PG8_BAR; PG8_MMA(0, 0, At, B0); PG8_MMA(0, 1, At, B1); PG8_BAR; PG8_SCHED;
            PG8_LDA(At, 1, 1); PG8_STAGE(PG8_SB(1, 0), b3, voffB); PG8_STAGE(PG8_SB(1, 1), b3 + hstep, voffB); PG8_STAGE(PG8_SA(1, 0), a3, voffA);
            PG8_WAIT_V(8); PG8_WAIT_L(0); PG8_BAR; PG8_MMA(1, 0, At, B0); PG8_MMA(1, 1, At, B1); PG8_BAR; PG8_SCHED;
            } else {
            PG8_LDB(B0, 0, 0); PG8_SCHED; PG8_LDA(At, 0, 0); PG8_STAGE(PG8_SA(1, 1), a1 + hstep, voffA);
            PG8_WAIT_L(8); PG8_BAR; PG8_WAIT_L(0); PG8_MMA(0, 0, At, B0); PG8_BAR; PG8_SCHED;
            PG8_LDB(B1, 0, 1); PG8_STAGE(PG8_SB(0, 0), b2, voffB);
            PG8_BAR; PG8_WAIT_L(0); PG8_MMA(0, 1, At, B1); PG8_BAR;
            PG8_LDA(At, 0, 1); PG8_STAGE(PG8_SA(0, 0), a2, voffA);
            PG8_BAR; PG8_WAIT_L(0); PG8_MMA(1, 0, At, B0); PG8_BAR; PG8_SCHED;
            PG8_STAGE(PG8_SB(0, 1), b2 + hstep, voffB);
            PG8_WAIT_V(6); PG8_BAR; PG8_MMA(1, 1, At, B1); PG8_BAR;
            PG8_LDB(B0, 1, 0); PG8_SCHED; PG8_LDA(At, 1, 0); PG8_STAGE(PG8_SA(0, 1), a2 + hstep, voffA);
            PG8_WAIT_L(8); PG8_BAR; PG8_WAIT_L(0); PG8_MMA(0, 0, At, B0); PG8_BAR; PG8_SCHED;
            PG8_LDB(B1, 1, 1); PG8_STAGE(PG8_SB(1, 0), b3, voffB);
            PG8_BAR; PG8_WAIT_L(0); PG8_MMA(0, 1, At, B1); PG8_BAR;
            PG8_LDA(At, 1, 1); PG8_STAGE(PG8_SA(1, 0), a3, voffA);
            PG8_BAR; PG8_WAIT_L(0); PG8_MMA(1, 0, At, B0); PG8_BAR; PG8_SCHED;
            PG8_STAGE(PG8_SB(1, 1), b3 + hstep, voffB);
            PG8_WAIT_V(6); PG8_BAR; PG8_MMA(1, 1, At, B1); PG8_BAR;
            }
        }
        if constexpr (ALIGN_EPI) { if (wr == 0) PG8_BAR; }
        if constexpr (!Epi::AFTER_DRAIN) { E(acc, cur, wr, wc, fr, fq); S.done(cur); }
        if (!has_next) break;
#pragma unroll
        for (int a = 0; a < 2; ++a)
#pragma unroll
            for (int b = 0; b < 2; ++b)
#pragma unroll
                for (int m = 0; m < 4; ++m)
#pragma unroll
                    for (int n = 0; n < 2; ++n) acc[a][b][m][n] = (f32x4){0.f, 0.f, 0.f, 0.f};
        cur = nxt; cA = nA; cB = nB; ++ui;
        if constexpr (ALIGN_EPI) { if (wr == 1) PG8_BAR; }
    }
    PG8_WAIT_V(0);
    if constexpr (!ALIGN_EPI) { if (wr == 0) PG8_BAR; }
    PG8_BAR;
    if constexpr (Epi::AFTER_DRAIN) { E.fused(acc, cur, wr, wc, fr, fq, lds, wid, lane); S.done(cur); }
#undef PG8_SA
#undef PG8_SB
#undef PG8_STAGE
#undef PG8_LDA
#undef PG8_LDB
#undef PG8_MMA
#undef PG8_WAIT_V
#undef PG8_WAIT_L
#undef PG8_BAR
#undef PG8_SCHED
}
}
namespace pg8 {
typedef float f32x2_t __attribute__((ext_vector_type(2))); typedef __bf16 bf16x2_t __attribute__((ext_vector_type(2)));
__device__ __forceinline__ unsigned cvt_pk_vis(float lo, float hi) { f32x2_t v = {lo, hi}; bf16x2_t b = __builtin_convertvector(v, bf16x2_t); return __builtin_bit_cast(unsigned, b); }
struct EpiProj {
    static constexpr bool PERM = true, AFTER_DRAIN = false;
    bf16_t* O; int ldc; bf16_t* halo; int halo_cols;
    __device__ __forceinline__ void operator()(const f32x4 (&acc)[2][2][4][2], const Unit& u, int wr, int wc, int fr, int fq) const {
        const int row0 = u.pm * BM + wr * 64 + fr, col0 = u.pn * BM + wc * 32 + 8 * fq;
#pragma unroll
        for (int ai = 0; ai < 2; ++ai)
#pragma unroll
            for (int m = 0; m < 4; ++m) { const int row = row0 + ai * HALF + m * 16; bf16_t* rowp = O + (size_t)row * ldc + col0;
#pragma unroll
                for (int bj = 0; bj < 2; ++bj) { const f32x4 v0 = acc[ai][bj][m][0], v1 = acc[ai][bj][m][1];
                    u32x4 w; w.x = cvt_pk_vis(v0[0], v0[1]); w.y = cvt_pk_vis(v0[2], v0[3]); w.z = cvt_pk_vis(v1[0], v1[1]); w.w = cvt_pk_vis(v1[2], v1[3]);
                    *(u32x4*)(rowp + bj * HALF) = w;
                    if (halo != nullptr && m == 3 && fr >= 13 && (col0 + bj * HALF) < halo_cols)
                        *(u32x4*)(halo + ((size_t)(row >> 6) * 3 + (fr - 13)) * halo_cols + col0 + bj * HALF) = w; } }
    }
};
struct EpiAxpy {
    static constexpr bool PERM = false, AFTER_DRAIN = false;
    const float* Xin; float* Xout; float alpha; int ldc;
    __device__ __forceinline__ void operator()(const f32x4 (&acc)[2][2][4][2], const Unit& u, int wr, int wc, int fr, int fq) const {
        const int row0 = u.pm * BM + wr * 64 + fr, col0 = u.pn * BM + wc * 32 + 4 * fq;
#pragma unroll
        for (int ai = 0; ai < 2; ++ai)
#pragma unroll
            for (int m = 0; m < 4; ++m) { const size_t ro = (size_t)(row0 + ai * HALF + m * 16) * ldc + col0;
#pragma unroll
                for (int bj = 0; bj < 2; ++bj)
#pragma unroll
                    for (int n = 0; n < 2; ++n) { const f32x4 xv = *(const f32x4*)(Xin + ro + bj * HALF + n * 16);
                        *(f32x4*)(Xout + ro + bj * HALF + n * 16) = xv * alpha + acc[ai][bj][m][n]; } }
    }
};
struct EpiSwiglu {
    static constexpr bool PERM = true, AFTER_DRAIN = false;
    bf16_t* Hh; int ldh;
    __device__ __forceinline__ void operator()(const f32x4 (&acc)[2][2][4][2], const Unit& u, int wr, int wc, int fr, int fq) const {
        const int row0 = u.pm * BM + wr * 64 + fr, col0 = u.pn * HALF + wc * 32 + 8 * fq;
#pragma unroll
        for (int ai = 0; ai < 2; ++ai)
#pragma unroll
            for (int m = 0; m < 4; ++m) { bf16_t* rowp = Hh + (size_t)(row0 + ai * HALF + m * 16) * ldh + col0;
                float hv[8];
#pragma unroll
                for (int n = 0; n < 2; ++n)
#pragma unroll
                    for (int e = 0; e < 4; ++e) { const float g = acc[ai][0][m][n][e], up = acc[ai][1][m][n][e];
                        hv[4 * n + e] = g * __builtin_amdgcn_rcpf(1.f + __expf(-g)) * up; }
                u32x4 w; w.x = cvt_pk_vis(hv[0], hv[1]); w.y = cvt_pk_vis(hv[2], hv[3]); w.z = cvt_pk_vis(hv[4], hv[5]); w.w = cvt_pk_vis(hv[6], hv[7]);
                *(u32x4*)rowp = w; }
    }
};
}
constexpr int NWAVES = 8;
constexpr int BATCH = 8, SEQ = 2048, D = 1024, M = BATCH * SEQ, NCH = SEQ / 64;
constexpr int FFH = 2816;
constexpr float DN_ALPHA = 1.6817928305074290f;
constexpr int N_PHASES = 33;
#ifndef MK_N_LAUNCHES
#define MK_N_LAUNCHES 1
#endif
constexpr int N_LAUNCHES = MK_N_LAUNCHES;

constexpr size_t MiB = 1u << 20;
constexpr size_t WS_CTL = 0, CTL_ZERO_BYTES = 65536;
constexpr size_t WS_W = 1 * MiB;
constexpr size_t W_IN = WS_W, W_OUT = W_IN + 8 * MiB, W_GU = W_OUT + 2 * MiB, W_DN = W_GU + 11 * MiB, W_AUX = W_DN + 6 * MiB;
constexpr size_t WS_XB = 29 * MiB;
constexpr size_t WS_O = 61 * MiB;
constexpr size_t WS_PROJ = 93 * MiB;
constexpr size_t WS_SCR = 221 * MiB;
constexpr size_t SCR_AUX = WS_SCR;
constexpr size_t SCR_DEC = WS_SCR + 1 * MiB;
constexpr size_t SCR_HALO = WS_SCR + 2 * MiB;
constexpr size_t SCR_KM = WS_SCR + 7 * MiB;
constexpr size_t SCR_PB = WS_SCR + 8 * MiB;
constexpr size_t WS_END = 256 * MiB;
static_assert(W_AUX + 65536 <= WS_XB && SCR_PB + 16 * MiB <= WS_END, "d_ws map");
constexpr int CW_BAR = 4096;

constexpr int RING_BYTES = 131072;
constexpr int LDSCTL_OFF = RING_BYTES, MISC_OFF = LDSCTL_OFF + 320;
constexpr int LDS_BYTES = 147456;

#define GAS __attribute__((address_space(1)))
#define LAS __attribute__((address_space(3)))
typedef unsigned short u16;
typedef short bf16x8 __attribute__((ext_vector_type(8)));
typedef short s16x4 __attribute__((ext_vector_type(4)));
typedef float f32x4 __attribute__((ext_vector_type(4)));
typedef unsigned u32x4 __attribute__((ext_vector_type(4)));
typedef unsigned u32x2 __attribute__((ext_vector_type(2)));
typedef GAS unsigned gu32;
#define RLX_AGENT __ATOMIC_RELAXED, __HIP_MEMORY_SCOPE_AGENT
#define LDS_WAIT() asm volatile("s_waitcnt lgkmcnt(0)" ::: "memory")
#define VM_WAIT() asm volatile("s_waitcnt vmcnt(0)" ::: "memory")
typedef float f32x2_t __attribute__((ext_vector_type(2))); typedef __bf16 bf16x2_t __attribute__((ext_vector_type(2)));
__device__ __forceinline__ unsigned pk2(float lo, float hi) { f32x2_t v = {lo, hi}; bf16x2_t b = __builtin_convertvector(v, bf16x2_t); return __builtin_bit_cast(unsigned, b); }
__device__ __forceinline__ u16 f2bf(float f) { return (u16)(pk2(f, 0.f) & 0xffffu); }
__device__ __forceinline__ float bf2f(unsigned b) { return __uint_as_float(b << 16); }
__device__ __forceinline__ float bflo(unsigned w) { return __uint_as_float(w << 16); }
__device__ __forceinline__ float bfhi(unsigned w) { return __uint_as_float(w & 0xffff0000u); }
__device__ __forceinline__ f32x4 mma16(bf16x8 a, bf16x8 b, f32x4 c) { return __builtin_amdgcn_mfma_f32_16x16x32_bf16(a, b, c, 0, 0, 0); }
__device__ __forceinline__ bf16x8 frag(const LAS u16* base, int pitch, int row, int k) { return *(const LAS bf16x8*)(base + row * pitch + k); }
__device__ __forceinline__ bf16x8 frag_perm(const LAS u16* base, int pitch, int row, int s, int q) {
    const s16x4 lo = *(const LAS s16x4*)(base + row * pitch + 32 * s + 4 * q), hi = *(const LAS s16x4*)(base + row * pitch + 32 * s + 16 + 4 * q);
    return (bf16x8){lo[0], lo[1], lo[2], lo[3], hi[0], hi[1], hi[2], hi[3]};
}
__device__ __forceinline__ bf16x8 acc2frag(f32x4 a0, f32x4 a1) { u32x4 w; w.x = pk2(a0[0], a0[1]); w.y = pk2(a0[2], a0[3]); w.z = pk2(a1[0], a1[1]); w.w = pk2(a1[2], a1[3]); return __builtin_bit_cast(bf16x8, w); }
__device__ __forceinline__ float wave_sum(float v) {
#pragma unroll
    for (int o = 1; o < 64; o <<= 1) v += __shfl_xor(v, o);
    return v;
}
__device__ __forceinline__ float lane_bcast(float v, int l) { return __uint_as_float((unsigned)__builtin_amdgcn_readlane((int)__float_as_uint(v), l)); }
__device__ __forceinline__ float sigmoidf_(float x) { return __builtin_amdgcn_rcpf(1.f + __expf(-x)); }
__device__ __forceinline__ float siluf_(float x) { return x * sigmoidf_(x); }
__device__ __forceinline__ float softplusf_(float x) { return fmaxf(x, 0.f) + __logf(1.f + __expf(-fabsf(x))); }
#define XB_TMO      128
#define XB_XCNT(j)  (256  + 64 * (j))
#define XB_XSUB(j)  (1280 + 64 * (j))
#define XB_XGEN(j)  (2304 + 64 * (j))
#define XB_TOP      3328
#define XB_TOPGEN   3392
#define XCD_BAR_WORDS 3456
#define XB_SPIN_CAP (1u << 18)

__device__ __forceinline__ unsigned xb_ld(unsigned* p)              { return __hip_atomic_load(p, __ATOMIC_RELAXED, __HIP_MEMORY_SCOPE_AGENT); }
__device__ __forceinline__ unsigned xb_add(unsigned* p, unsigned v) { return __hip_atomic_fetch_add(p, v, __ATOMIC_RELAXED, __HIP_MEMORY_SCOPE_AGENT); }
__device__ __forceinline__ unsigned xb_xcc_id() { return (unsigned)__builtin_amdgcn_s_getreg((3 << 11) | 20) & 0xFu; }
#define XB_SPIN(cond, bar) do { unsigned _sp = 0; while (cond) { __builtin_amdgcn_s_sleep(1); \
    if ((++_sp & 255u) == 0u) { if (xb_ld(&(bar)[XB_TMO])) break; if (_sp > XB_SPIN_CAP) { atomicAdd(&(bar)[XB_TMO], 1u); break; } } } } while (0)

struct XcdBarrier {
    unsigned* bar; unsigned x;
    volatile LAS unsigned* st;
};

__device__ __forceinline__ XcdBarrier xcd_barrier_post(unsigned* bar, volatile LAS unsigned* st) {
    XcdBarrier b; b.bar = bar; b.x = xb_xcc_id(); b.st = st;
    if (threadIdx.x == 0) (void)xb_add(&bar[XB_XCNT(b.x)], 1u);
    return b;
}
__device__ __forceinline__ void xcd_barrier_complete(unsigned* bar, unsigned x, unsigned& nloc, unsigned& nx) {
    const unsigned G = gridDim.x * gridDim.y * gridDim.z;
    unsigned sum, cnt, mine, sp = 0u;
    for (;;) {
        sum = 0u; cnt = 0u; mine = 0u;
#pragma unroll
        for (unsigned j = 0; j < 16; ++j) { const unsigned c = xb_ld(&bar[XB_XCNT(j)]); sum += c; cnt += (c > 0u) ? 1u : 0u; mine = (j == x) ? c : mine; }
        if (sum == G) break;
        __builtin_amdgcn_s_sleep(1);
        if ((++sp & 255u) == 0u) { if (xb_ld(&bar[XB_TMO])) break; if (sp > XB_SPIN_CAP) { atomicAdd(&bar[XB_TMO], 1u); break; } }
    }
    nloc = mine > 0u ? mine : 1u; nx = cnt > 0u ? cnt : 1u;
}

__device__ __forceinline__ void xcd_barrier(const XcdBarrier& b) {
    asm volatile("s_waitcnt vmcnt(0)" ::: "memory");
    __syncthreads();
    if (threadIdx.x == 0) {
        unsigned* bar = b.bar;
        __builtin_amdgcn_s_waitcnt(0);
        unsigned nloc = b.st[0], nx = b.st[1];
        if (nloc == 0u) { xcd_barrier_complete(bar, b.x, nloc, nx); b.st[0] = nloc; b.st[1] = nx; }
        const unsigned old = xb_add(&bar[XB_XSUB(b.x)], 1u);
        const unsigned gen = old / nloc;
        if (old + 1u == (gen + 1u) * nloc) {
            __builtin_amdgcn_fence(__ATOMIC_RELEASE, "agent");
            asm volatile("s_waitcnt vmcnt(0)" ::: "memory");
            const unsigned og = xb_add(&bar[XB_TOP], 1u);
            const unsigned tg = og / nx;
            if (og + 1u == (tg + 1u) * nx) xb_add(&bar[XB_TOPGEN], 1u);
            else XB_SPIN(xb_ld(&bar[XB_TOPGEN]) == tg, bar);
            __builtin_amdgcn_fence(__ATOMIC_ACQUIRE, "agent");
            xb_add(&bar[XB_XGEN(b.x)], 1u);
            asm volatile("s_waitcnt vmcnt(0)" ::: "memory");
        } else {
            XB_SPIN(xb_ld(&bar[XB_XGEN(b.x)]) == gen, bar);
            __builtin_amdgcn_fence(__ATOMIC_ACQUIRE, "agent");
            asm volatile("s_waitcnt vmcnt(0)" ::: "memory");
        }
    }
    __syncthreads();
}
struct Frame {
    LAS unsigned char* lds;
    volatile LAS unsigned* MISC;
    gu32* ctl;
    int tid, lane, wave, G;
    unsigned char* ws;
    const float* in[23];
    float* out;
};
struct Args { const float* in[23]; float* out; unsigned char* ws; int ph_lo, ph_hi, li, pad; };

__device__ __forceinline__ void tr_item(const float* W, int ldw, int k0, int nsrc0, int nvalid, u16* WT, int K, int ndst0, LAS float* scr, int lane) {
    const int nn = (lane & 31) % nvalid;
#pragma unroll 8
    for (int i = 0; i < 32; ++i) { const int kk = 2 * i + (lane >> 5); scr[kk * 33 + (lane & 31)] = W[(size_t)(k0 + kk) * ldw + nsrc0 + nn]; }
    LDS_WAIT(); asm volatile("" ::: "memory");
    const int c = lane & 7;
#pragma unroll
    for (int j = 0; j < 4; ++j) { const int n = (lane >> 3) + 8 * j; const LAS float* s = scr + (8 * c) * 33 + n;
        u32x4 o; o.x = pk2(s[0 * 33], s[1 * 33]); o.y = pk2(s[2 * 33], s[3 * 33]); o.z = pk2(s[4 * 33], s[5 * 33]); o.w = pk2(s[6 * 33], s[7 * 33]);
        *(GAS u32x4*)(WT + (size_t)(ndst0 + n) * K + k0 + 8 * c) = o; }
    LDS_WAIT(); asm volatile("" ::: "memory");
}
template <int L> __device__ __forceinline__ void convert_layer_weights(Frame& F) {
    LAS float* scr = (LAS float*)(F.lds + F.wave * 16384);
    const int gw = blockIdx.x * NWAVES + F.wave, NGW = F.G * NWAVES;
    constexpr int w_in_idx = (L == 0) ? 2 : (L == 1) ? 7 : (L == 2) ? 9 : 16;
    constexpr int w_out_idx = (L == 0) ? 6 : (L == 1) ? 8 : (L == 2) ? 14 : 18;
    constexpr int NIN = (L == 0) ? 3072 : (L == 1) ? 3072 : 4096;
    constexpr int LDIN = (L == 0) ? 3088 : (L == 1) ? 3072 : (L == 2) ? 4112 : 4096;
    constexpr bool HAS_AUX = (L == 0 || L == 2);
    const float* w_in = F.in[w_in_idx]; const float* w_out = F.in[w_out_idx];
    const float* w_gu = F.in[19] + (size_t)L * D * 2 * FFH; const float* w_dn = F.in[20] + (size_t)L * FFH * D;
    u16* WIN = (u16*)(F.ws + W_IN); u16* WOUT = (u16*)(F.ws + W_OUT); u16* WGU = (u16*)(F.ws + W_GU); u16* WDN = (u16*)(F.ws + W_DN); u16* WAUX = (u16*)(F.ws + W_AUX);
    constexpr int I_IN = (D / 64) * (NIN / 32), I_AUX = HAS_AUX ? (D / 64) : 0, I_OUT = (D / 64) * (D / 32), I_GU = (D / 64) * (2 * FFH / 32), I_DN = (FFH / 64) * (D / 32);
    constexpr int NITEMS = I_IN + I_AUX + I_OUT + I_GU + I_DN;
    for (int it = gw; it < NITEMS; it += NGW) {
        int r = it;
        if (r < I_IN) { const int nb = NIN / 32, kb = r / nb, nbi = r % nb; tr_item(w_in, LDIN, 64 * kb, 32 * nbi, 32, WIN, D, 32 * nbi, scr, F.lane); continue; } r -= I_IN;
        if (r < I_AUX) { tr_item(w_in, LDIN, 64 * r, NIN, 16, WAUX, D, 0, scr, F.lane); continue; } r -= I_AUX;
        if (r < I_OUT) { const int nb = D / 32, kb = r / nb, nbi = r % nb; tr_item(w_out, D, 64 * kb, 32 * nbi, 32, WOUT, D, 32 * nbi, scr, F.lane); continue; } r -= I_OUT;
        if (r < I_GU) { const int nb = 2 * FFH / 32, kb = r / nb, nbi = r % nb; const int nd = 32 * nbi, tile = nd >> 8, within = nd & 255;
            const int ns = (within < 128) ? (tile * 128 + within) : (FFH + tile * 128 + (within - 128));
            tr_item(w_gu, 2 * FFH, 64 * kb, ns, 32, WGU, D, nd, scr, F.lane); continue; } r -= I_GU;
        { const int nb = D / 32, kb = r / nb, nbi = r % nb; tr_item(w_dn, D, 64 * kb, 32 * nbi, 32, WDN, FFH, 32 * nbi, scr, F.lane); }
    }
}
__device__ __forceinline__ void x_to_bf16(Frame& F) {
    const float* x = F.in[0]; u16* XB = (u16*)(F.ws + WS_XB);
    const size_t n8 = (size_t)M * D / 8;
    for (size_t i = (size_t)blockIdx.x * 512 + F.tid; i < n8; i += (size_t)F.G * 512) {
        const f32x4 a = *(const f32x4*)(x + i * 8), b = *(const f32x4*)(x + i * 8 + 4);
        u32x4 w; w.x = pk2(a[0], a[1]); w.y = pk2(a[2], a[3]); w.z = pk2(b[0], b[1]); w.w = pk2(b[2], b[3]);
        *(u32x4*)(XB + i * 8) = w; }
}
__device__ __forceinline__ void ln_phase(Frame& F, const float* g, const float* bta) {
    float* X = F.out; u16* XB = (u16*)(F.ws + WS_XB);
    const int gw = blockIdx.x * NWAVES + F.wave, NGW = F.G * NWAVES;
    f32x4 gv[4], bv[4];
#pragma unroll
    for (int j = 0; j < 4; ++j) { gv[j] = *(const f32x4*)(g + 4 * F.lane + 256 * j); bv[j] = *(const f32x4*)(bta + 4 * F.lane + 256 * j); }
    for (int m = gw; m < M; m += NGW) {
        float* xr = X + (size_t)m * D + 4 * F.lane;
        f32x4 v[4]; float s = 0.f;
#pragma unroll
        for (int j = 0; j < 4; ++j) { v[j] = *(const f32x4*)(xr + 256 * j); s += (v[j][0] + v[j][1]) + (v[j][2] + v[j][3]); }
        const float mean = wave_sum(s) * (1.f / D); float s2 = 0.f;
#pragma unroll
        for (int j = 0; j < 4; ++j) { v[j] = v[j] - mean; s2 += (v[j][0] * v[j][0] + v[j][1] * v[j][1]) + (v[j][2] * v[j][2] + v[j][3] * v[j][3]); }
        const float rstd = 1.f / sqrtf(wave_sum(s2) * (1.f / D) + 1e-5f);
        u16* xb = XB + (size_t)m * D + 4 * F.lane;
#pragma unroll
        for (int j = 0; j < 4; ++j) { const f32x4 y = v[j] * rstd * gv[j] + bv[j]; *(f32x4*)(xr + 256 * j) = y;
            u32x2 w; w.x = pk2(y[0], y[1]); w.y = pk2(y[2], y[3]); *(u32x2*)(xb + 256 * j) = w; }
    }
}
__device__ __forceinline__ void aux_proj(Frame& F) {
    const u16* XB = (const u16*)(F.ws + WS_XB); const u16* WA = (const u16*)(F.ws + W_AUX); float* AUX = (float*)(F.ws + SCR_AUX);
    const int r = F.lane & 15, q = F.lane >> 4;
    for (int gi = blockIdx.x * NWAVES + F.wave; gi < M / 16; gi += F.G * NWAVES) {
        const u16* ap = XB + (size_t)(gi * 16 + r) * D + 8 * q; const u16* bp = WA + (size_t)r * D + 8 * q;
        f32x4 acc = {0.f, 0.f, 0.f, 0.f};
#pragma unroll 8
        for (int s = 0; s < 32; ++s) { const bf16x8 a = *(const bf16x8*)(ap + 32 * s), b = *(const bf16x8*)(bp + 32 * s); acc = mma16(a, b, acc); }
#pragma unroll
        for (int e = 0; e < 4; ++e) AUX[(size_t)(gi * 16 + 4 * q + e) * 16 + r] = acc[e];
    }
}
template <bool HG> __device__ __forceinline__ void gla_prep(Frame& F) {
    constexpr int H = HG ? 8 : 4, PITCH = HG ? 4096 : 3072, KCOL = HG ? 1024 : 512, PH = H * 64;
    u16* PROJ = (u16*)(F.ws + WS_PROJ); u16* PB = (u16*)(F.ws + SCR_PB); float* DEC = (float*)(F.ws + SCR_DEC); const float* AUX = (const float*)(F.ws + SCR_AUX);
    LAS u16* Qd = (LAS u16*)(F.lds); LAS u16* Ki = (LAS u16*)(F.lds + 17408); LAS float* Wg = (LAS float*)(F.lds + 34816);
    const int t = F.lane, c0 = 16 * F.wave, r = F.lane & 15, q = F.lane >> 4;
    const float qscale = HG ? 1.f : 0.08838834764831845f;
    for (int it = blockIdx.x; it < BATCH * H * NCH; it += F.G) {
        const int n = it % NCH, h = (it / NCH) % H, b = it / (NCH * H);
        const int row0 = b * SEQ + n * 64, row = row0 + t;
        u16* qp = PROJ + (size_t)row * PITCH + h * 128 + c0; u16* kp = PROJ + (size_t)row * PITCH + KCOL + h * 128 + c0;
        const u32x4 q0 = *(const u32x4*)qp, q1 = *(const u32x4*)(qp + 8), k0 = *(const u32x4*)kp, k1 = *(const u32x4*)(kp + 8);
        float qv[16], kv[16], lg[16];
#pragma unroll
        for (int i = 0; i < 4; ++i) { qv[2 * i] = bflo(q0[i]); qv[2 * i + 1] = bfhi(q0[i]); qv[8 + 2 * i] = bflo(q1[i]); qv[8 + 2 * i + 1] = bfhi(q1[i]);
                                      kv[2 * i] = bflo(k0[i]); kv[2 * i + 1] = bfhi(k0[i]); kv[8 + 2 * i] = bflo(k1[i]); kv[8 + 2 * i + 1] = bfhi(k1[i]); }
        if constexpr (!HG) {
            const float* w_gk = F.in[3]; const float* b_gk = F.in[4];
            for (int i = F.tid; i < 16 * 128; i += 512) Wg[i] = w_gk[(size_t)(i >> 7) * 512 + h * 128 + (i & 127)];
            if (F.tid < 128) Wg[2048 + F.tid] = b_gk[h * 128 + F.tid];
            float gl[16];
#pragma unroll
            for (int i = 0; i < 4; ++i) { const f32x4 g4 = *(const f32x4*)(AUX + (size_t)row * 16 + 4 * i); gl[4 * i] = g4[0]; gl[4 * i + 1] = g4[1]; gl[4 * i + 2] = g4[2]; gl[4 * i + 3] = g4[3]; }
            VM_WAIT(); __syncthreads();
#pragma unroll
            for (int c4 = 0; c4 < 4; ++c4) { f32x4 z = *(const LAS f32x4*)(Wg + 2048 + c0 + 4 * c4);
#pragma unroll
                for (int rr = 0; rr < 16; ++rr) { const f32x4 w4 = *(const LAS f32x4*)(Wg + rr * 128 + c0 + 4 * c4); z = z + w4 * gl[rr]; }
#pragma unroll
                for (int e = 0; e < 4; ++e) lg[4 * c4 + e] = -softplusf_(-z[e]) * (1.f / 16.f); }
        } else {
            const float* lbp = F.in[15];
#pragma unroll
            for (int c = 0; c < 16; ++c) { const int col = h * 128 + c0 + c;
                const float l0 = lbp[col], l1 = lbp[1024 + col], l2 = lbp[2048 + col], l3 = lbp[3072 + col];
                const float mx = fmaxf(fmaxf(l0, l1), fmaxf(l2, l3)), e0 = __expf(l0 - mx), e1 = __expf(l1 - mx), e2 = __expf(l2 - mx), e3 = __expf(l3 - mx);
                const float lb = (e1 + e2 + e3) / (e0 + e1 + e2 + e3);
                const float f = kv[c], ef = __expf(-f), sg = 1.f / (1.f + ef), sn = ef / (1.f + ef);
                lg[c] = __logf(lb + (1.f - lb) * sg); kv[c] = (1.f - lb) * sn; }
            VM_WAIT(); __syncthreads();
        }
        float cum[16];
#pragma unroll
        for (int c = 0; c < 16; ++c) { float x = lg[c];
#pragma unroll
            for (int d = 1; d < 64; d <<= 1) { const float y = __shfl_up(x, d); if (t >= d) x += y; }
            cum[c] = x; }
        unsigned qd[8], ki[8];
        u16 ke[16]; float dl[16];
#pragma unroll
        for (int c = 0; c < 16; c += 2) {
            const float la = lane_bcast(cum[c], 63), lb2 = lane_bcast(cum[c + 1], 63);
            dl[c] = la; dl[c + 1] = lb2;
            qd[c >> 1] = pk2(qv[c] * qscale * __expf(cum[c]), qv[c + 1] * qscale * __expf(cum[c + 1]));
            ki[c >> 1] = pk2(kv[c] * __expf(-cum[c]), kv[c + 1] * __expf(-cum[c + 1]));
            const unsigned kk = pk2(kv[c] * __expf(la - cum[c]), kv[c + 1] * __expf(lb2 - cum[c + 1]));
            ke[c] = (u16)(kk & 0xffffu); ke[c + 1] = (u16)(kk >> 16); }
        *(LAS u32x4*)(Qd + t * 136 + c0) = (u32x4){qd[0], qd[1], qd[2], qd[3]}; *(LAS u32x4*)(Qd + t * 136 + c0 + 8) = (u32x4){qd[4], qd[5], qd[6], qd[7]};
        *(LAS u32x4*)(Ki + t * 136 + c0) = (u32x4){ki[0], ki[1], ki[2], ki[3]}; *(LAS u32x4*)(Ki + t * 136 + c0 + 8) = (u32x4){ki[4], ki[5], ki[6], ki[7]};
        *(u32x4*)qp = (u32x4){qd[0], qd[1], qd[2], qd[3]}; *(u32x4*)(qp + 8) = (u32x4){qd[4], qd[5], qd[6], qd[7]};
#pragma unroll
        for (int c = 0; c < 16; ++c) { const int d = c0 + c; PROJ[(size_t)(row0 + (d >> 1)) * PITCH + KCOL + h * 128 + (d & 1) * 64 + t] = ke[c]; }
        if (t == 0) {
#pragma unroll
            for (int c = 0; c < 16; ++c) DEC[(size_t)it * 128 + c0 + c] = __expf(dl[c]); }
        __syncthreads();
#pragma unroll
        for (int tl = 0; tl < 2; ++tl) { const int tile = 2 * F.wave + tl, ti = tile >> 2, tj = tile & 3;
            f32x4 acc = {0.f, 0.f, 0.f, 0.f};
            if (tj <= ti) {
#pragma unroll
                for (int s = 0; s < 4; ++s) acc = mma16(frag(Ki, 136, 16 * tj + r, 32 * s + 8 * q), frag(Qd, 136, 16 * ti + r, 32 * s + 8 * q), acc); }
            const int i = 16 * ti + r, j0 = 16 * tj + 4 * q;
            float p[4];
#pragma unroll
            for (int e = 0; e < 4; ++e) p[e] = (j0 + e <= i) ? acc[e] : 0.f;
            u32x2 w; w.x = pk2(p[0], p[1]); w.y = pk2(p[2], p[3]);
            *(u32x2*)(PB + (size_t)(row0 + i) * PH + h * 64 + j0) = w; }
        __syncthreads();
    }
}
template <int KIND> __device__ __forceinline__ void scan_phase(Frame& F) {
    constexpr bool DELTA = (KIND == 2);
    constexpr int DV = (KIND == 0) ? 256 : 128, H = (KIND == 0) ? 4 : 8, DVW = DV / 8, CT = DVW / 16, PH = H * 64;
    constexpr int PITCH = (KIND == 0) ? 3072 : 4096;
    constexpr int QCOL = 0, KCOL = (KIND == 0) ? 512 : 1024, VCOL = (KIND == 0) ? 1024 : 2048, GCOL = (KIND == 0) ? 2048 : 3072;
    const u16* PROJ = (const u16*)(F.ws + WS_PROJ); const u16* PB = (const u16*)(F.ws + SCR_PB); const float* DEC = (const float*)(F.ws + SCR_DEC);
    const u16* WB = (const u16*)(F.ws + WS_XB); u16* OB = (u16*)(F.ws + WS_O);
    const float* norm_g = F.in[(KIND == 0) ? 5 : (KIND == 1) ? 17 : 13];
    LAS u16* Pm = (LAS u16*)(F.lds); LAS u16* Qd = (LAS u16*)(F.lds + 9216); LAS u16* KeT = (LAS u16*)(F.lds + 26624); LAS u16* Wm = (LAS u16*)(F.lds + 45056);
    LAS u16* VT = (LAS u16*)(F.lds + 62464 + F.wave * (DVW * 72 * 2)); LAS float* decs = (LAS float*)(F.lds + 99328); LAS float* ssq = (LAS float*)(F.lds + 99840);
    const int tid = F.tid, r = F.lane & 15, q = F.lane >> 4, w = F.wave;
    f32x4 ng[CT];
#pragma unroll
    for (int ct = 0; ct < CT; ++ct) ng[ct] = *(const f32x4*)(norm_g + DVW * w + 16 * ct + 4 * q);
    for (int item = blockIdx.x; item < BATCH * H; item += F.G) {
        const int b = item / H, h = item % H;
        f32x4 Sacc[8][CT];
#pragma unroll
        for (int dt = 0; dt < 8; ++dt)
#pragma unroll
            for (int ct = 0; ct < CT; ++ct) Sacc[dt][ct] = (f32x4){0.f, 0.f, 0.f, 0.f};
        u32x4 pP, pQ[2], pK[2], pW[2], pV[DVW / 8]; u32x2 pU[4]; float pD;
#define SCAN_PREFETCH(nn) do { const int row0_ = b * SEQ + (nn) * 64; \
            pP = *(const u32x4*)(PB + (size_t)(row0_ + (tid >> 3)) * PH + h * 64 + (tid & 7) * 8); \
            _Pragma("unroll") for (int k_ = 0; k_ < 2; ++k_) { const int id_ = tid + 512 * k_; \
                pQ[k_] = *(const u32x4*)(PROJ + (size_t)(row0_ + (id_ >> 4)) * PITCH + QCOL + h * 128 + (id_ & 15) * 8); \
                const int d_ = id_ >> 3; \
                pK[k_] = *(const u32x4*)(PROJ + (size_t)(row0_ + (d_ >> 1)) * PITCH + KCOL + h * 128 + (d_ & 1) * 64 + (id_ & 7) * 8); \
                if constexpr (DELTA) pW[k_] = *(const u32x4*)(WB + (size_t)(row0_ + (id_ >> 4)) * D + h * 128 + (id_ & 15) * 8); } \
            if constexpr (DELTA) { _Pragma("unroll") for (int tt_ = 0; tt_ < 4; ++tt_) pU[tt_] = *(const u32x2*)(PROJ + (size_t)(row0_ + 16 * tt_ + r) * PITCH + VCOL + h * DV + DVW * w + 4 * q); \
                pD = DEC[(size_t)item * NCH + (nn)]; } \
            else { _Pragma("unroll") for (int k_ = 0; k_ < DVW / 8; ++k_) pV[k_] = *(const u32x4*)(PROJ + (size_t)(row0_ + F.lane) * PITCH + VCOL + h * DV + DVW * w + 8 * k_); \
                pD = (tid < 128) ? DEC[((size_t)item * NCH + (nn)) * 128 + tid] : 0.f; } } while (0)
        SCAN_PREFETCH(0);
        for (int n = 0; n < NCH; ++n) {
            const int row0 = b * SEQ + n * 64;
            __syncthreads();
            *(LAS u32x4*)(Pm + (tid >> 3) * 72 + (tid & 7) * 8) = pP;
#pragma unroll
            for (int k = 0; k < 2; ++k) { const int id = tid + 512 * k;
                *(LAS u32x4*)(Qd + (id >> 4) * 136 + (id & 15) * 8) = pQ[k];
                *(LAS u32x4*)(KeT + (id >> 3) * 72 + (id & 7) * 8) = pK[k];
                if constexpr (DELTA) *(LAS u32x4*)(Wm + (id >> 4) * 136 + (id & 15) * 8) = pW[k]; }
            f32x4 uu[4]; float dsc = 1.f;
            if constexpr (DELTA) {
#pragma unroll
                for (int tt = 0; tt < 4; ++tt) uu[tt] = (f32x4){bflo(pU[tt].x), bfhi(pU[tt].x), bflo(pU[tt].y), bfhi(pU[tt].y)};
                dsc = pD;
            } else {
                if (tid < 128) decs[tid] = pD;
#pragma unroll
                for (int k = 0; k < DVW / 8; ++k)
#pragma unroll
                    for (int i = 0; i < 4; ++i) { VT[(8 * k + 2 * i) * 72 + F.lane] = (u16)(pV[k][i] & 0xffffu); VT[(8 * k + 2 * i + 1) * 72 + F.lane] = (u16)(pV[k][i] >> 16); }
            }
            __syncthreads();
            if (n + 1 < NCH) SCAN_PREFETCH(n + 1);
            if constexpr (DELTA) {
                f32x4 a4[4];
#pragma unroll
                for (int tt = 0; tt < 4; ++tt) a4[tt] = (f32x4){0.f, 0.f, 0.f, 0.f};
#pragma unroll
                for (int s = 0; s < 4; ++s) { const bf16x8 sfr = acc2frag(Sacc[2 * s][0], Sacc[2 * s + 1][0]);
#pragma unroll
                    for (int tt = 0; tt < 4; ++tt) a4[tt] = mma16(sfr, frag_perm(Wm, 136, 16 * tt + r, s, q), a4[tt]); }
#pragma unroll
                for (int tt = 0; tt < 4; ++tt) { const f32x4 vn = uu[tt] - a4[tt];
#pragma unroll
                    for (int e = 0; e < 4; ++e) VT[(4 * q + e) * 72 + 16 * tt + r] = f2bf(vn[e]); }
                LDS_WAIT();
            }
            f32x4 oacc[4][CT];
#pragma unroll
            for (int it = 0; it < 4; ++it)
#pragma unroll
                for (int ct = 0; ct < CT; ++ct) { f32x4 a = {0.f, 0.f, 0.f, 0.f};
#pragma unroll
                    for (int s = 0; s < 2; ++s) if (32 * s <= 16 * it + 15) a = mma16(frag(VT, 72, 16 * ct + r, 32 * s + 8 * q), frag(Pm, 72, 16 * it + r, 32 * s + 8 * q), a);
                    oacc[it][ct] = a; }
#pragma unroll
            for (int s = 0; s < 4; ++s) { bf16x8 sfr[CT];
#pragma unroll
                for (int ct = 0; ct < CT; ++ct) sfr[ct] = acc2frag(Sacc[2 * s][ct], Sacc[2 * s + 1][ct]);
#pragma unroll
                for (int it = 0; it < 4; ++it) { const bf16x8 qfr = frag_perm(Qd, 136, 16 * it + r, s, q);
#pragma unroll
                    for (int ct = 0; ct < CT; ++ct) oacc[it][ct] = mma16(sfr[ct], qfr, oacc[it][ct]); } }
#pragma unroll
            for (int dt = 0; dt < 8; ++dt) { f32x4 dv4;
                if constexpr (DELTA) dv4 = (f32x4){dsc, dsc, dsc, dsc}; else dv4 = *(const LAS f32x4*)(decs + 16 * dt + 4 * q);
#pragma unroll
                for (int ct = 0; ct < CT; ++ct) { f32x4 a = Sacc[dt][ct] * dv4;
#pragma unroll
                    for (int s = 0; s < 2; ++s) a = mma16(frag(KeT, 72, 16 * dt + r, 32 * s + 8 * q), frag(VT, 72, 16 * ct + r, 32 * s + 8 * q), a);
                    Sacc[dt][ct] = a; } }
            u32x2 gt[4][CT];
#pragma unroll
            for (int it = 0; it < 4; ++it)
#pragma unroll
                for (int ct = 0; ct < CT; ++ct) gt[it][ct] = *(const u32x2*)(PROJ + (size_t)(row0 + 16 * it + r) * PITCH + GCOL + h * DV + DVW * w + 16 * ct + 4 * q);
#pragma unroll
            for (int it = 0; it < 4; ++it) { float ss = 0.f;
#pragma unroll
                for (int ct = 0; ct < CT; ++ct) ss += (oacc[it][ct][0] * oacc[it][ct][0] + oacc[it][ct][1] * oacc[it][ct][1]) + (oacc[it][ct][2] * oacc[it][ct][2] + oacc[it][ct][3] * oacc[it][ct][3]);
                ss += __shfl_xor(ss, 16); ss += __shfl_xor(ss, 32);
                if (q == 0) ssq[(16 * it + r) * 8 + w] = ss; }
            __syncthreads();
#pragma unroll
            for (int it = 0; it < 4; ++it) { const f32x4 s0 = *(const LAS f32x4*)(ssq + (16 * it + r) * 8), s1 = *(const LAS f32x4*)(ssq + (16 * it + r) * 8 + 4);
                const float tot = ((s0[0] + s0[1]) + (s0[2] + s0[3])) + ((s1[0] + s1[1]) + (s1[2] + s1[3]));
                const float rs = 1.f / sqrtf(tot * (1.f / DV) + 1e-6f);
#pragma unroll
                for (int ct = 0; ct < CT; ++ct) { const float g0 = bflo(gt[it][ct].x), g1 = bfhi(gt[it][ct].x), g2 = bflo(gt[it][ct].y), g3 = bfhi(gt[it][ct].y);
                    const f32x4 o = oacc[it][ct] * rs * ng[ct];
                    float o0 = o[0] * siluf_(g0), o1 = o[1] * siluf_(g1), o2 = o[2] * siluf_(g2), o3 = o[3] * siluf_(g3);
#ifdef DBG_SANITIZE
                    if (!(fabsf(o0) < 1e4f)) o0 = 0.f; if (!(fabsf(o1) < 1e4f)) o1 = 0.f; if (!(fabsf(o2) < 1e4f)) o2 = 0.f; if (!(fabsf(o3) < 1e4f)) o3 = 0.f;
#endif
                    u32x2 wv; wv.x = pk2(o0, o1); wv.y = pk2(o2, o3);
                    *(u32x2*)(OB + (size_t)(row0 + 16 * it + r) * D + h * DV + DVW * w + 16 * ct + 4 * q) = wv; } }
        }
#undef SCAN_PREFETCH
        __syncthreads();
    }
}
__device__ __forceinline__ void gdn_prep(Frame& F) {
    constexpr int H = 8, PITCH = 4096, PH = 512;
    u16* PROJ = (u16*)(F.ws + WS_PROJ); u16* PB = (u16*)(F.ws + SCR_PB); float* DEC = (float*)(F.ws + SCR_DEC); const float* AUX = (const float*)(F.ws + SCR_AUX);
    const u16* HALO = (const u16*)(F.ws + SCR_HALO); u16* WB = (u16*)(F.ws + WS_XB);
    const float* conv_w = F.in[10]; const float* a_log = F.in[11]; const float* dt_bias = F.in[12];
    LAS u16* Qn = (LAS u16*)(F.lds); LAS u16* Kn = (LAS u16*)(F.lds + 17408); LAS u16* VBT = (LAS u16*)(F.lds + 34816); LAS u16* KDT = (LAS u16*)(F.lds + 53248);
    LAS float* Lm = (LAS float*)(F.lds + 71680);
    LAS u16* Tm = (LAS u16*)(F.lds + 89088);
    LAS float* red = (LAS float*)(F.lds + 98304);
    LAS float* rowv = (LAS float*)(F.lds + 102400);
    LAS float* cw = (LAS float*)(F.lds + 103424);
    const int c0 = 16 * F.wave, w = F.wave;
    for (int it = blockIdx.x; it < BATCH * H * NCH; it += F.G) {
        int t; asm volatile("v_mov_b32 %0, %1" : "=v"(t) : "v"(F.lane));
        const int r = t & 15, q = t >> 4;
        const int n = it % NCH, h = (it / NCH) % H, b = it / (NCH * H);
        const int row0 = b * SEQ + n * 64, row = row0 + t, gch = row0 >> 6;
        for (int i = F.tid; i < 1536; i += 512) cw[i] = conv_w[(size_t)(i / 384) * 3072 + ((i / 128) % 3) * 1024 + h * 128 + (i & 127)];
        __syncthreads();
        float xq[16], xk[16], xv[16];
        int vz; asm volatile("v_mov_b32 %0, 0" : "=v"(vz));
#pragma unroll
        for (int c = 0; c < 16; ++c) { xq[c] = 0.f; xk[c] = 0.f; xv[c] = 0.f; }
#pragma unroll 1
        for (int j = 0; j < 4; ++j) { const int tp = t - 3 + j;
            const u16* src; bool ok = true;
            if (tp >= 0) src = PROJ + (size_t)(row0 + tp) * PITCH + h * 128 + c0;
            else { src = HALO + ((size_t)(gch - 1) * 3 + (3 + tp)) * 3072 + h * 128 + c0; ok = (n > 0); }
#if defined(DBG_GDN) && (DBG_GDN & 1)
            if (tp < 0) ok = false;
#endif
            u32x4 a0 = {0u, 0u, 0u, 0u}, a1 = a0, b0 = a0, b1 = a0, d0 = a0, d1 = a0;
            if (ok) { const int ps = (tp >= 0) ? 1024 : 1024;
                a0 = *(const u32x4*)src; a1 = *(const u32x4*)(src + 8); b0 = *(const u32x4*)(src + ps); b1 = *(const u32x4*)(src + ps + 8); d0 = *(const u32x4*)(src + 2 * ps); d1 = *(const u32x4*)(src + 2 * ps + 8); }
            const LAS float* wq = cw + j * 384 + c0 + vz;
#pragma unroll
            for (int i4 = 0; i4 < 4; ++i4) { const f32x4 wa = *(const LAS f32x4*)(wq + 4 * i4), wb = *(const LAS f32x4*)(wq + 128 + 4 * i4), wc = *(const LAS f32x4*)(wq + 256 + 4 * i4);
                const u32x4& A = (i4 < 2) ? a0 : a1; const u32x4& Bv = (i4 < 2) ? b0 : b1; const u32x4& Dv = (i4 < 2) ? d0 : d1; const int o2 = (i4 & 1) * 2;
                xq[4 * i4 + 0] += wa[0] * bflo(A[o2]); xq[4 * i4 + 1] += wa[1] * bfhi(A[o2]); xq[4 * i4 + 2] += wa[2] * bflo(A[o2 + 1]); xq[4 * i4 + 3] += wa[3] * bfhi(A[o2 + 1]);
                xk[4 * i4 + 0] += wb[0] * bflo(Bv[o2]); xk[4 * i4 + 1] += wb[1] * bfhi(Bv[o2]); xk[4 * i4 + 2] += wb[2] * bflo(Bv[o2 + 1]); xk[4 * i4 + 3] += wb[3] * bfhi(Bv[o2 + 1]);
                xv[4 * i4 + 0] += wc[0] * bflo(Dv[o2]); xv[4 * i4 + 1] += wc[1] * bfhi(Dv[o2]); xv[4 * i4 + 2] += wc[2] * bflo(Dv[o2 + 1]); xv[4 * i4 + 3] += wc[3] * bfhi(Dv[o2 + 1]); }
        }
        float sq = 0.f, sk = 0.f;
#pragma unroll
        for (int c = 0; c < 16; ++c) { xq[c] = siluf_(xq[c]); xk[c] = siluf_(xk[c]); xv[c] = siluf_(xv[c]); sq += xq[c] * xq[c]; sk += xk[c] * xk[c]; }
        red[t * 8 + w] = sq; red[512 + t * 8 + w] = sk;
        const float beta = sigmoidf_(AUX[(size_t)row * 16 + 8 + h]);
        const float gg = -__expf(a_log[h]) * softplusf_(AUX[(size_t)row * 16 + h] + dt_bias[h]);
        float cum = gg;
#pragma unroll
        for (int d = 1; d < 64; d <<= 1) { const float y = __shfl_up(cum, d); if (t >= d) cum += y; }
        const float last = lane_bcast(cum, 63);
        if (w == 0) { rowv[t] = beta; rowv[64 + t] = cum; }
        VM_WAIT(); __syncthreads();
        float tq = 0.f, tk = 0.f;
        { const f32x4 s0 = *(const LAS f32x4*)(red + t * 8), s1 = *(const LAS f32x4*)(red + t * 8 + 4), k0 = *(const LAS f32x4*)(red + 512 + t * 8), k1 = *(const LAS f32x4*)(red + 512 + t * 8 + 4);
          tq = ((s0[0] + s0[1]) + (s0[2] + s0[3])) + ((s1[0] + s1[1]) + (s1[2] + s1[3])); tk = ((k0[0] + k0[1]) + (k0[2] + k0[3])) + ((k1[0] + k1[1]) + (k1[2] + k1[3])); }
        const float rq = 0.08838834764831845f / sqrtf(tq + 1e-6f), rk = 1.f / sqrtf(tk + 1e-6f);
        const float ec = __expf(cum), ee = __expf(last - cum);
        unsigned qn[8], kn[8], qdv[8];
#pragma unroll
        for (int c = 0; c < 16; c += 2) { const float qa = xq[c] * rq, qb = xq[c + 1] * rq, ka = xk[c] * rk, kb = xk[c + 1] * rk;
            qn[c >> 1] = pk2(qa, qb); kn[c >> 1] = pk2(ka, kb); qdv[c >> 1] = pk2(qa * ec, qb * ec);
            const unsigned vb = pk2(xv[c] * beta, xv[c + 1] * beta), kd = pk2(ka * beta * ec, kb * beta * ec), ke = pk2(ka * ee, kb * ee);
            VBT[(c0 + c) * 72 + t] = (u16)(vb & 0xffffu); VBT[(c0 + c + 1) * 72 + t] = (u16)(vb >> 16);
            KDT[(c0 + c) * 72 + t] = (u16)(kd & 0xffffu); KDT[(c0 + c + 1) * 72 + t] = (u16)(kd >> 16);
            const int d = c0 + c;
            PROJ[(size_t)(row0 + (d >> 1)) * PITCH + 1024 + h * 128 + (d & 1) * 64 + t] = (u16)(ke & 0xffffu);
            PROJ[(size_t)(row0 + ((d + 1) >> 1)) * PITCH + 1024 + h * 128 + ((d + 1) & 1) * 64 + t] = (u16)(ke >> 16); }
        *(LAS u32x4*)(Qn + t * 136 + c0) = (u32x4){qn[0], qn[1], qn[2], qn[3]}; *(LAS u32x4*)(Qn + t * 136 + c0 + 8) = (u32x4){qn[4], qn[5], qn[6], qn[7]};
        *(LAS u32x4*)(Kn + t * 136 + c0) = (u32x4){kn[0], kn[1], kn[2], kn[3]}; *(LAS u32x4*)(Kn + t * 136 + c0 + 8) = (u32x4){kn[4], kn[5], kn[6], kn[7]};
        { u16* qp = PROJ + (size_t)row * PITCH + h * 128 + c0; *(u32x4*)qp = (u32x4){qdv[0], qdv[1], qdv[2], qdv[3]}; *(u32x4*)(qp + 8) = (u32x4){qdv[4], qdv[5], qdv[6], qdv[7]}; }
        if (F.tid == 0) DEC[it] = __expf(last);
        __syncthreads();
#pragma unroll
        for (int tl = 0; tl < 2; ++tl) { const int tile = 2 * w + tl, ti = tile >> 2, tj = tile & 3;
            f32x4 akk = {0.f, 0.f, 0.f, 0.f}, aqk = akk;
            if (tj <= ti) {
#pragma unroll
                for (int s = 0; s < 4; ++s) { const bf16x8 kj = frag(Kn, 136, 16 * tj + r, 32 * s + 8 * q);
                    akk = mma16(kj, frag(Kn, 136, 16 * ti + r, 32 * s + 8 * q), akk); aqk = mma16(kj, frag(Qn, 136, 16 * ti + r, 32 * s + 8 * q), aqk); } }
            const int i = 16 * ti + r, j0 = 16 * tj + 4 * q;
            const float bi = rowv[i], ci = rowv[64 + i]; const f32x4 cj = *(const LAS f32x4*)(rowv + 64 + j0);
            f32x4 lv; float pq[4];
#pragma unroll
            for (int e = 0; e < 4; ++e) { const float dcy = (j0 + e <= i) ? __expf(ci - cj[e]) : 0.f; lv[e] = (j0 + e < i) ? bi * akk[e] * dcy : 0.f; pq[e] = aqk[e] * dcy; }
            *(LAS f32x4*)(Lm + i * 68 + j0) = lv;
            u32x2 wv; wv.x = pk2(pq[0], pq[1]); wv.y = pk2(pq[2], pq[3]);
            *(u32x2*)(PB + (size_t)(row0 + i) * PH + h * 64 + j0) = wv; }
        __syncthreads();
        {
            float x[8];
            const int tv = t;
#pragma unroll
            for (int cc = 0; cc < 8; ++cc) x[cc] = (tv == 8 * w + cc) ? 1.f : 0.f;
#pragma unroll
            for (int j4 = 0; j4 < 16; ++j4) {
                if (4 * j4 + 3 >= 8 * w) {
                    const f32x4 l4 = *(const LAS f32x4*)(Lm + t * 68 + 4 * j4);
#pragma unroll
                    for (int e = 0; e < 4; ++e) { const int j = 4 * j4 + e;
                        if (j < 63) {
#pragma unroll
                            for (int cc = 0; cc < 8; ++cc) { const float xj = lane_bcast(x[cc], j); x[cc] -= (tv > j) ? l4[e] * xj : 0.f; } } } }
            }
            u32x4 tw; tw.x = pk2(x[0], x[1]); tw.y = pk2(x[2], x[3]); tw.z = pk2(x[4], x[5]); tw.w = pk2(x[6], x[7]);
            *(LAS u32x4*)(Tm + t * 72 + 8 * w) = tw;
        }
        __syncthreads();
#pragma unroll
        for (int tt = 0; tt < 4; ++tt) { f32x4 au = {0.f, 0.f, 0.f, 0.f}, aw = au;
#pragma unroll
            for (int s = 0; s < 2; ++s) if (32 * s <= 16 * tt + 15) { const bf16x8 tf = frag(Tm, 72, 16 * tt + r, 32 * s + 8 * q);
                au = mma16(frag(VBT, 72, c0 + r, 32 * s + 8 * q), tf, au); aw = mma16(frag(KDT, 72, c0 + r, 32 * s + 8 * q), tf, aw); }
            u32x2 wu, ww; wu.x = pk2(au[0], au[1]); wu.y = pk2(au[2], au[3]); ww.x = pk2(aw[0], aw[1]); ww.y = pk2(aw[2], aw[3]);
            *(u32x2*)(PROJ + (size_t)(row0 + 16 * tt + r) * PITCH + 2048 + h * 128 + c0 + 4 * q) = wu;
            *(u32x2*)(WB + (size_t)(row0 + 16 * tt + r) * D + h * 128 + c0 + 4 * q) = ww; }
        __syncthreads();
    }
}
__device__ __forceinline__ void moba_prep(Frame& F) {
    constexpr int PITCH = 3072;
    u16* PROJ = (u16*)(F.ws + WS_PROJ); float* KM = (float*)(F.ws + SCR_KM); u16* VTG = (u16*)(F.ws + WS_XB);
    const int* pos = (const int*)F.in[1];
    LAS u16* T0 = (LAS u16*)(F.lds);
    LAS float* part = (LAS float*)(F.lds + 73728);
    const int tid = F.tid;
    for (int it = blockIdx.x; it < BATCH * 8 * 8; it += F.G) {
        const int blk = it & 7, h = (it >> 3) & 7, b = it >> 6;
        const int row0 = b * SEQ + blk * 256;
#pragma unroll 4
        for (int k = 0; k < 16; ++k) { const int id = tid + 512 * k, which = id >> 12, rr = (id >> 4) & 255, i = id & 15;
            const float p = (float)pos[row0 + rr];
            const float inv = exp2f(-(float)i * (18.931568569324174f / 16.f));
            const float rev = p * inv * 0.15915494309189535f, fr = rev - floorf(rev);
            const float sn = __builtin_amdgcn_sinf(fr), cs = __builtin_amdgcn_cosf(fr);
            u16* ptr = PROJ + (size_t)(row0 + rr) * PITCH + which * 1024 + h * 128 + i;
            const float x1 = bf2f(ptr[0]), x2 = bf2f(ptr[16]);
            ptr[0] = f2bf(x1 * cs - x2 * sn); ptr[16] = f2bf(x2 * cs + x1 * sn); }
        VM_WAIT(); __syncthreads();
#pragma unroll
        for (int k = 0; k < 8; ++k) { const int id = tid + 512 * k, rr = id >> 4, part16 = id & 15;
            *(LAS u32x4*)(T0 + rr * 136 + part16 * 8) = __builtin_nontemporal_load((const u32x4*)(PROJ + (size_t)(row0 + rr) * PITCH + 1024 + h * 128 + part16 * 8)); }
        __syncthreads();
        { const int d = tid & 127, qq = tid >> 7; float s = 0.f;
#pragma unroll 8
          for (int rr = 0; rr < 64; ++rr) s += bf2f(T0[(qq * 64 + rr) * 136 + d]);
          part[qq * 128 + d] = s; }
        __syncthreads();
        if (tid < 128) KM[((size_t)(b * 8 + h) * 8 + blk) * 128 + tid] = (part[tid] + part[128 + tid] + part[256 + tid] + part[384 + tid]) * (1.f / 256.f);
        __syncthreads();
#pragma unroll
        for (int k = 0; k < 8; ++k) { const int id = tid + 512 * k, rr = id >> 4, part16 = id & 15;
            *(LAS u32x4*)(T0 + rr * 136 + part16 * 8) = *(const u32x4*)(PROJ + (size_t)(row0 + rr) * PITCH + 2048 + h * 128 + part16 * 8); }
        __syncthreads();
#pragma unroll
        for (int k = 0; k < 8; ++k) { const int id = tid + 512 * k, d = id >> 5, t8 = (id & 31) * 8;
            unsigned wv[4];
#pragma unroll
            for (int i = 0; i < 4; ++i) wv[i] = (unsigned)T0[(t8 + 2 * i) * 136 + d] | ((unsigned)T0[(t8 + 2 * i + 1) * 136 + d] << 16);
            *(u32x4*)(VTG + ((size_t)(b * 8 + h) * 128 + d) * SEQ + blk * 256 + t8) = (u32x4){wv[0], wv[1], wv[2], wv[3]}; }
        __syncthreads();
    }
}
__device__ __forceinline__ void moba_attn(Frame& F) {
    constexpr int PITCH = 3072;
    const u16* PROJ = (const u16*)(F.ws + WS_PROJ); const float* KMg = (const float*)(F.ws + SCR_KM); const u16* VTG = (const u16*)(F.ws + WS_XB); u16* OB = (u16*)(F.ws + WS_O);
    LAS float* KM = (LAS float*)(F.lds + 73728);
    const int tid = F.tid, r = F.lane & 15, q = F.lane >> 4, w = F.wave;
    constexpr float C2 = 0.08838834764831845f * 1.4426950408889634f;
    for (int pr = blockIdx.x; pr < 256; pr += F.G) {
        const int bh = pr >> 2, b = bh >> 3, h = bh & 7;
        __syncthreads();
        for (int i = tid; i < 1024; i += 512) KM[i] = KMg[(size_t)bh * 1024 + i];
        __syncthreads();
#pragma unroll 1
        for (int pass = 0; pass < 2; ++pass) {
            const int qb = pass ? (pr & 3) : 7 - (pr & 3);
            const int rowb = b * SEQ + qb * 256 + 32 * w;
            bf16x8 qf[2][4]; unsigned sel[2];
#pragma unroll
            for (int rt = 0; rt < 2; ++rt) {
#pragma unroll
                for (int s = 0; s < 4; ++s) qf[rt][s] = *(const bf16x8*)(PROJ + (size_t)(rowb + 16 * rt + r) * PITCH + h * 128 + 32 * s + 8 * q);
                float g[8];
#pragma unroll
                for (int j = 0; j < 8; ++j) { float a = 0.f;
                    if (j < qb) {
#pragma unroll
                        for (int s = 0; s < 4; ++s) { const f32x4 k0 = *(const LAS f32x4*)(KM + j * 128 + 32 * s + 8 * q), k1 = *(const LAS f32x4*)(KM + j * 128 + 32 * s + 8 * q + 4);
                            const u32x4 qw = __builtin_bit_cast(u32x4, qf[rt][s]);
                            a += bflo(qw[0]) * k0[0] + bfhi(qw[0]) * k0[1] + bflo(qw[1]) * k0[2] + bfhi(qw[1]) * k0[3] + bflo(qw[2]) * k1[0] + bfhi(qw[2]) * k1[1] + bflo(qw[3]) * k1[2] + bfhi(qw[3]) * k1[3]; }
                        a += __shfl_xor(a, 16); a += __shfl_xor(a, 32); }
                    g[j] = a; }
                unsigned m = 0u;
#pragma unroll
                for (int j = 0; j < 8; ++j) { int rank = 0;
#pragma unroll
                    for (int i = 0; i < 8; ++i) if (i != j) rank += (i < qb && (g[i] > g[j] || (g[i] == g[j] && i < j))) ? 1 : 0;
                    if (j < qb && rank < 3) m |= (1u << j); }
                sel[rt] = m; }
            f32x4 oacc[2][8]; float mrow[2], lrow[2];
#pragma unroll
            for (int rt = 0; rt < 2; ++rt) { mrow[rt] = -1e30f; lrow[rt] = 0.f;
#pragma unroll
                for (int dt = 0; dt < 8; ++dt) oacc[rt][dt] = (f32x4){0.f, 0.f, 0.f, 0.f}; }
            const int NT = 4 * (qb + 1);
            u32x4 pk[2], pv[2];
#define MOBA_LOAD(T_) do { const int blk_ = ((T_) < 4) ? qb : (((T_) - 4) >> 2), kt_ = ((T_) < 4) ? (T_) : (((T_) - 4) & 3), kb_ = blk_ * 256 + kt_ * 64; \
                _Pragma("unroll") for (int k_ = 0; k_ < 2; ++k_) { const int id_ = tid + 512 * k_; \
                    pk[k_] = *(const u32x4*)(PROJ + (size_t)(b * SEQ + kb_ + (id_ >> 4)) * PITCH + 1024 + h * 128 + (id_ & 15) * 8); \
                    pv[k_] = *(const u32x4*)(VTG + ((size_t)bh * 128 + (id_ >> 3)) * SEQ + kb_ + (id_ & 7) * 8); } } while (0)
#define MOBA_STORE(buf_) do { LAS u16* Kt_ = (LAS u16*)(F.lds + (buf_) * 35840); LAS u16* Vt_ = Kt_ + 64 * 136; \
                _Pragma("unroll") for (int k_ = 0; k_ < 2; ++k_) { const int id_ = tid + 512 * k_; \
                    *(LAS u32x4*)(Kt_ + (id_ >> 4) * 136 + (id_ & 15) * 8) = pk[k_]; *(LAS u32x4*)(Vt_ + (id_ >> 3) * 72 + (id_ & 7) * 8) = pv[k_]; } } while (0)
            MOBA_LOAD(0);
            __syncthreads();
            MOBA_STORE(0);
            __syncthreads();
            for (int T = 0; T < NT; ++T) {
                if (T + 1 < NT) MOBA_LOAD(T + 1);
                const LAS u16* Kt = (const LAS u16*)(F.lds + (T & 1) * 35840); const LAS u16* Vt = Kt + 64 * 136;
                const bool own = (T < 4); const int blk = own ? qb : ((T - 4) >> 2), kt = own ? T : ((T - 4) & 3);
                const bool active = !own || (kt <= (w >> 1));
                if (active) {
                    f32x4 sc[2][4];
#pragma unroll
                    for (int kq = 0; kq < 4; ++kq) { f32x4 a0 = {0.f, 0.f, 0.f, 0.f}, a1 = a0;
#pragma unroll
                        for (int s = 0; s < 4; ++s) { const bf16x8 kf = frag(Kt, 136, 16 * kq + r, 32 * s + 8 * q); a0 = mma16(kf, qf[0][s], a0); a1 = mma16(kf, qf[1][s], a1); }
                        sc[0][kq] = a0; sc[1][kq] = a1; }
                    bf16x8 pf[2][2];
#pragma unroll
                    for (int rt = 0; rt < 2; ++rt) {
                        const int rin = 32 * w + 16 * rt + r;
                        const bool rowsel = own || ((sel[rt] >> blk) & 1u);
                        float mx = -__builtin_inff();
#pragma unroll
                        for (int kq = 0; kq < 4; ++kq)
#pragma unroll
                            for (int e = 0; e < 4; ++e) { const int kin = 64 * kt + 16 * kq + 4 * q + e;
                                const bool ok = rowsel && (!own || kin <= rin);
                                const float v = ok ? sc[rt][kq][e] : -__builtin_inff(); sc[rt][kq][e] = v; mx = fmaxf(mx, v); }
                        mx = fmaxf(mx, __shfl_xor(mx, 16)); mx = fmaxf(mx, __shfl_xor(mx, 32));
                        const float mnew = fmaxf(mrow[rt], mx), alpha = __builtin_amdgcn_exp2f((mrow[rt] - mnew) * C2), mb = mnew * C2;
                        mrow[rt] = mnew;
                        float ps = 0.f;
#pragma unroll
                        for (int kq = 0; kq < 4; ++kq)
#pragma unroll
                            for (int e = 0; e < 4; ++e) { const float p = __builtin_amdgcn_exp2f(sc[rt][kq][e] * C2 - mb); sc[rt][kq][e] = p; ps += p; }
                        ps += __shfl_xor(ps, 16); ps += __shfl_xor(ps, 32);
                        lrow[rt] = lrow[rt] * alpha + ps;
#pragma unroll
                        for (int dt = 0; dt < 8; ++dt) oacc[rt][dt] = oacc[rt][dt] * alpha;
                        pf[rt][0] = acc2frag(sc[rt][0], sc[rt][1]); pf[rt][1] = acc2frag(sc[rt][2], sc[rt][3]); }
#pragma unroll
                    for (int dt = 0; dt < 8; ++dt)
#pragma unroll
                        for (int s2 = 0; s2 < 2; ++s2) { const bf16x8 vf = frag_perm(Vt, 72, 16 * dt + r, s2, q);
                            oacc[0][dt] = mma16(vf, pf[0][s2], oacc[0][dt]); oacc[1][dt] = mma16(vf, pf[1][s2], oacc[1][dt]); }
                }
                if (T + 1 < NT) MOBA_STORE((T + 1) & 1);
                __syncthreads();
            }
#undef MOBA_LOAD
#undef MOBA_STORE
#pragma unroll
            for (int rt = 0; rt < 2; ++rt) { const float il = 1.f / lrow[rt];
#pragma unroll
                for (int dt = 0; dt < 8; ++dt) { const f32x4 o = oacc[rt][dt] * il; u32x2 wv; wv.x = pk2(o[0], o[1]); wv.y = pk2(o[2], o[3]);
                    *(u32x2*)(OB + (size_t)(rowb + 16 * rt + r) * D + h * 128 + 16 * dt + 4 * q) = wv; } }
        }
    }
}
#define IN_(k) (lo <= (k) && (k) < hi)
#define BOTH_(k) (IN_(k) && IN_((k) + 1))
#define GRID_BAR() do { if (N_LAUNCHES == 1) xcd_barrier(bar); } while (0)

template <int L> __device__ __forceinline__ void layer_phases(Frame& F, const XcdBarrier& bar, const int lo, const int hi) {
    constexpr int base = 1 + 8 * L;
    constexpr int NIN = (L == 0 || L == 1) ? 3072 : 4096;
    u16* XB = (u16*)(F.ws + WS_XB); u16* PROJ = (u16*)(F.ws + WS_PROJ); u16* OB = (u16*)(F.ws + WS_O);
    if (IN_(base + 0)) {
        if constexpr (L == 0 || L == 2) aux_proj(F);
        pg8::Gemm g{XB, (const u16*)(F.ws + W_IN), M, NIN, D}; pg8::StaticOrder S; S.init(M, NIN, F.G, (int)blockIdx.x);
        pg8::EpiProj E{PROJ, NIN, (L == 2) ? (u16*)(F.ws + SCR_HALO) : (u16*)nullptr, 3072};
        pg8::gemm_phase<pg8::EpiProj, pg8::StaticOrder, true, true>(F.lds, g, S, E);
        if (BOTH_(base + 0)) GRID_BAR();
    }
#ifndef DBG_SKIP
#define DBG_SKIP 0
#endif
    constexpr bool SKIPM = ((DBG_SKIP >> L) & 1) != 0;
    if (IN_(base + 1) && !SKIPM) {
        if constexpr (L == 0) gla_prep<false>(F);
        if constexpr (L == 1) moba_prep(F);
        if constexpr (L == 2) gdn_prep(F);
        if constexpr (L == 3) gla_prep<true>(F);
    }
    if (IN_(base + 1) && BOTH_(base + 1)) GRID_BAR();
    if (IN_(base + 2) && SKIPM) { for (size_t i = (size_t)blockIdx.x * 512 + F.tid; i < (size_t)M * D / 8; i += (size_t)F.G * 512) *(u32x4*)(OB + i * 8) = (u32x4){0u, 0u, 0u, 0u}; }
    if (IN_(base + 2) && !SKIPM) {
        if constexpr (L == 0) scan_phase<0>(F);
        if constexpr (L == 1) moba_attn(F);
        if constexpr (L == 2) scan_phase<2>(F);
        if constexpr (L == 3) scan_phase<1>(F);
    }
    if (IN_(base + 2) && BOTH_(base + 2)) GRID_BAR();
    if (IN_(base + 3)) {
        pg8::Gemm g{OB, (const u16*)(F.ws + W_OUT), M, D, D}; pg8::StaticOrder S; S.init(M, D, F.G, (int)blockIdx.x);
        pg8::EpiAxpy E{(L == 0) ? F.in[0] : (const float*)F.out, F.out, DN_ALPHA, D};
        pg8::gemm_phase<pg8::EpiAxpy, pg8::StaticOrder, true, true>(F.lds, g, S, E);
        if (BOTH_(base + 3)) GRID_BAR();
    }
    if (IN_(base + 4)) { ln_phase(F, F.in[21] + (size_t)(2 * L) * D, F.in[22] + (size_t)(2 * L) * D); if (BOTH_(base + 4)) GRID_BAR(); }
    if (IN_(base + 5)) {
        pg8::Gemm g{XB, (const u16*)(F.ws + W_GU), M, 2 * FFH, D}; pg8::StaticOrder S; S.init(M, 2 * FFH, F.G, (int)blockIdx.x);
        pg8::EpiSwiglu E{PROJ, FFH};
        pg8::gemm_phase<pg8::EpiSwiglu, pg8::StaticOrder, true, true>(F.lds, g, S, E);
        if (BOTH_(base + 5)) GRID_BAR();
    }
    if (IN_(base + 6)) {
        pg8::Gemm g{PROJ, (const u16*)(F.ws + W_DN), M, D, FFH}; pg8::StaticOrder S; S.init(M, D, F.G, (int)blockIdx.x);
        pg8::EpiAxpy E{(const float*)F.out, F.out, DN_ALPHA, D};
        pg8::gemm_phase<pg8::EpiAxpy, pg8::StaticOrder, true, true>(F.lds, g, S, E);
        if (BOTH_(base + 6)) GRID_BAR();
    }
    if (IN_(base + 7)) {
        ln_phase(F, F.in[21] + (size_t)(2 * L + 1) * D, F.in[22] + (size_t)(2 * L + 1) * D);
        if constexpr (L < 3) { convert_layer_weights<L + 1>(F); if (BOTH_(base + 7)) GRID_BAR(); }
    }
}

__global__ void __launch_bounds__(NWAVES * 64, 2) fwd(Args args) {
    extern __shared__ __attribute__((aligned(16))) unsigned char lds[];
    Frame F;
    F.lds = (LAS unsigned char*)lds;
    F.MISC = (volatile LAS unsigned*)(F.lds + MISC_OFF);
    F.tid = threadIdx.x; F.lane = F.tid & 63; F.wave = __builtin_amdgcn_readfirstlane(F.tid >> 6); F.G = gridDim.x;
    F.ws = args.ws; F.ctl = (gu32*)(args.ws + WS_CTL); F.out = args.out;
#pragma unroll
    for (int i = 0; i < 23; ++i) F.in[i] = args.in[i];
    for (int u = F.tid; u < (LDS_BYTES - LDSCTL_OFF) / 4; u += NWAVES * 64) ((LAS unsigned*)(F.lds + LDSCTL_OFF))[u] = 0u;
    __syncthreads();
    XcdBarrier bar; bar.bar = (unsigned*)(F.ctl + CW_BAR); bar.x = 0; bar.st = nullptr;
    if (N_LAUNCHES == 1) bar = xcd_barrier_post((unsigned*)(F.ctl + CW_BAR), F.MISC + 8);
    const int lo = args.ph_lo, hi = args.ph_hi;
    if (IN_(0)) { convert_layer_weights<0>(F); x_to_bf16(F); if (BOTH_(0)) GRID_BAR(); }
    layer_phases<0>(F, bar, lo, hi);
    layer_phases<1>(F, bar, lo, hi);
    layer_phases<2>(F, bar, lo, hi);
    layer_phases<3>(F, bar, lo, hi);
}

extern "C" void kernel_launch(void* const* d_in, const int* in_sizes, int n_in, void* d_out, int out_size, void* d_ws, size_t ws_size, hipStream_t stream) {
    static int grid = 0;
    if (grid == 0) {
        if (n_in != 23 || in_sizes[0] != M * D || out_size != M * D || ws_size < WS_END) { fprintf(stderr, "kernel_launch: unexpected shapes (n_in %d, in0 %d, out %d, ws %zu)\n", n_in, n_in > 0 ? in_sizes[0] : -1, out_size, ws_size); grid = -1; return; }
        int dev = 0, cus = 0, per_cu = 0;
        if (hipGetDevice(&dev) != hipSuccess || hipDeviceGetAttribute(&cus, hipDeviceAttributeMultiprocessorCount, dev) != hipSuccess) { grid = -1; return; }
        if (hipFuncSetAttribute((const void*)fwd, hipFuncAttributeMaxDynamicSharedMemorySize, LDS_BYTES) != hipSuccess) { fprintf(stderr, "kernel_launch: hipFuncSetAttribute failed\n"); grid = -1; return; }
        if (hipOccupancyMaxActiveBlocksPerMultiprocessor(&per_cu, (const void*)fwd, NWAVES * 64, LDS_BYTES) != hipSuccess || per_cu < 1) fprintf(stderr, "kernel_launch: occupancy query reports %d\n", per_cu);
        (void)hipGetLastError();
        grid = cus;
    }
    if (grid < 0) return;
    if (hipMemsetAsync((char*)d_ws + WS_CTL, 0, CTL_ZERO_BYTES, stream) != hipSuccess) return;
    Args a{};
    for (int i = 0; i < 23; ++i) a.in[i] = (const float*)d_in[i];
    a.out = (float*)d_out; a.ws = (unsigned char*)d_ws; a.pad = 0;
    for (int li = 0; li < N_LAUNCHES; ++li) {
        if (N_LAUNCHES == 1) { a.ph_lo = 0; a.ph_hi = N_PHASES; } else { a.ph_lo = li; a.ph_hi = li + 1; }
        a.li = li;
        hipLaunchKernelGGL(fwd, dim3(grid), dim3(NWAVES * 64), LDS_BYTES, stream, a);
    }
}
```
